# Optimizing an MI355X kernel written in HIP

```python
import math
import jax, jax.numpy as jnp
from jax import lax
import numpy as np

D_MODEL = 1024
BATCH = 2
SEQ = 8192
DEPTH = 1

CHUNK = 64
BAND_PREV = 8
BAND = (BAND_PREV + 1) * CHUNK
REL_CLIP = 256
N_REL = REL_CLIP + CHUNK

W_A = D_MODEL // 2
HEAD_A = 64
H_A = W_A // HEAD_A
W_B = D_MODEL // 2
HEAD_B = 64
H_B = W_B // HEAD_B
DECAY_LORA = 64
A_LORA = 64
GATE_LORA = 128
D_FF = 4 * D_MODEL

ATT_COLS = 3 * W_A
RWKV_COLS = 3 * W_B + DECAY_LORA + A_LORA + GATE_LORA
GATE_COLS = 2 * D_MODEL
IN_COLS = ATT_COLS + RWKV_COLS + GATE_COLS

RMS_EPS = 1e-6
GN_EPS = HEAD_B * 1e-5
NEG_INF = -1e30

kernel_name = "chunked_attn_rwkv7_gated_hybrid"


def rms_norm(x, g):
    xf = x.astype(jnp.float32)
    y = xf * lax.rsqrt(jnp.mean(xf * xf, axis=-1, keepdims=True) + RMS_EPS)
    return (y * g.astype(jnp.float32)).astype(x.dtype)


def chunk_band_attention(q, k, v, rel_bias):
    b, s, h, d = q.shape
    nc = s // CHUNK
    qc = q.reshape(b, nc, CHUNK, h, d)
    pad = ((0, 0), (BAND_PREV * CHUNK, 0), (0, 0), (0, 0))
    kp = jnp.pad(k, pad).reshape(b, nc + BAND_PREV, CHUNK, h, d)
    vp = jnp.pad(v, pad).reshape(b, nc + BAND_PREV, CHUNK, h, d)
    kb = jnp.concatenate([kp[:, o:o + nc] for o in range(BAND_PREV + 1)], axis=2)
    vb = jnp.concatenate([vp[:, o:o + nc] for o in range(BAND_PREV + 1)], axis=2)
    scores = jnp.einsum('bnqhd,bnkhd->bnhqk', qc, kb).astype(jnp.float32) * (d ** -0.5)
    qi = jnp.arange(CHUNK)[:, None]
    kj = jnp.arange(BAND)[None, :]
    dist = qi + BAND_PREV * CHUNK - kj
    idx = jnp.clip(dist, -(CHUNK - 1), REL_CLIP) + (CHUNK - 1)
    bias = rel_bias.astype(jnp.float32)[:, idx]
    valid = (jnp.arange(nc)[:, None] - BAND_PREV + kj // CHUNK) >= 0
    scores = jnp.where(valid[None, :, None, None, :], scores + bias[None, None], NEG_INF)
    p = jax.nn.softmax(scores, axis=-1)
    out = jnp.einsum('bnhqk,bnkhd->bnqhd', p.astype(vb.dtype), vb)
    return out.reshape(b, s, h * d)


def rwkv7_time_mix(p, shift_mu, w0, w2, a0, a2, g2, k_k, k_a, r_k, ln_x_w, ln_x_b):
    b, s, _ = p.shape
    prev = jnp.pad(p, ((0, 0), (1, 0), (0, 0)))[:, :-1]
    p = p + (prev - p) * shift_mu
    splits = [W_B, 2 * W_B, 3 * W_B, 3 * W_B + DECAY_LORA, 3 * W_B + DECAY_LORA + A_LORA]
    r, k, v, cw, ca, cg = jnp.split(p, splits, axis=-1)
    w_log = -jax.nn.softplus(-(w0 + jnp.tanh(cw) @ w2)) - 0.5
    decay = jnp.exp(-jnp.exp(w_log.astype(jnp.float32)))
    a = jax.nn.sigmoid(a0 + ca @ a2)
    g = jax.nn.sigmoid(cg) @ g2

    def heads(t):
        return t.reshape(b, s, H_B, HEAD_B).astype(jnp.float32)

    kk = heads(k * k_k)
    kk = kk / jnp.maximum(jnp.sqrt(jnp.sum(kk * kk, axis=-1, keepdims=True)), 1e-12)
    k = k * (1.0 + (a - 1.0) * k_a)
    r_h, k_h, v_h, a_h, w_h = heads(r), heads(k), heads(v), heads(a), heads(decay)

    def step(state, inp):
        r_t, w_t, k_t, v_t, aa_t, bb_t = inp
        sa = jnp.einsum('bhij,bhj->bhi', state, aa_t)
        state = (state * w_t[:, :, None, :] + sa[..., None] * bb_t[:, :, None, :]
                 + v_t[..., None] * k_t[:, :, None, :])
        y = jnp.einsum('bhij,bhj->bhi', state, r_t)
        return state, y

    xs = tuple(jnp.moveaxis(t, 1, 0) for t in (r_h, w_h, k_h, v_h, -kk, kk * a_h))
    init = jnp.zeros((b, H_B, HEAD_B, HEAD_B), jnp.float32)
    _, ys = lax.scan(step, init, xs)
    y = jnp.moveaxis(ys, 0, 1)
    mu = jnp.mean(y, axis=-1, keepdims=True)
    var = jnp.mean(jnp.square(y - mu), axis=-1, keepdims=True)
    yn = (y - mu) * lax.rsqrt(var + GN_EPS)
    gn_w = ln_x_w.reshape(H_B, HEAD_B).astype(jnp.float32)
    gn_b = ln_x_b.reshape(H_B, HEAD_B).astype(jnp.float32)
    yn = yn * gn_w + gn_b
    bonus = jnp.sum(r_h * k_h * r_k.astype(jnp.float32), axis=-1, keepdims=True) * v_h
    out = (yn + bonus) * heads(g)
    return out.reshape(b, s, W_B).astype(p.dtype)


def setup_inputs(seed: int = 0) -> dict:
    key = jax.random.key(seed)
    ks = jax.random.split(key, 24)
    L = DEPTH

    def nrm(k, shape, scale):
        return jax.random.normal(k, shape, jnp.float32) * scale

    return {
        "x": nrm(ks[0], (BATCH, SEQ, D_MODEL), 1.0),
        "pre_mix_g": 1.0 + nrm(ks[1], (L, D_MODEL), 0.05),
        "w_in": nrm(ks[2], (L, D_MODEL, IN_COLS), D_MODEL ** -0.5),
        "gate_bias": nrm(ks[3], (L, GATE_COLS), 0.1),
        "rel_bias": nrm(ks[4], (L, H_A, N_REL), 0.5),
        "shift_mu": jax.random.uniform(ks[5], (L, RWKV_COLS), jnp.float32),
        "w0": jax.random.uniform(ks[6], (L, W_B), jnp.float32, -5.0, 0.5),
        "w2": nrm(ks[7], (L, DECAY_LORA, W_B), 0.1),
        "a0": nrm(ks[8], (L, W_B), 0.1),
        "a2": nrm(ks[9], (L, A_LORA, W_B), A_LORA ** -0.5),
        "g2": nrm(ks[10], (L, GATE_LORA, W_B), GATE_LORA ** -0.5),
        "k_k": 0.85 + nrm(ks[11], (L, W_B), 0.05),
        "k_a": 1.0 + nrm(ks[12], (L, W_B), 0.05),
        "r_k": nrm(ks[13], (L, H_B, HEAD_B), 0.1),
        "ln_x_w": 1.0 + nrm(ks[14], (L, W_B), 0.05),
        "ln_x_b": nrm(ks[15], (L, W_B), 0.05),
        "proj_a": nrm(ks[16], (L, W_A, D_MODEL), W_A ** -0.5),
        "proj_b": nrm(ks[17], (L, W_B, D_MODEL), W_B ** -0.5),
        "w_out": nrm(ks[18], (L, D_MODEL, D_MODEL), D_MODEL ** -0.5),
        "post_mix_g": 1.0 + nrm(ks[19], (L, D_MODEL), 0.05),
        "pre_ffn_g": 1.0 + nrm(ks[20], (L, D_MODEL), 0.05),
        "w_up": nrm(ks[21], (L, D_MODEL, D_FF), D_MODEL ** -0.5),
        "w_down": nrm(ks[22], (L, D_FF, D_MODEL), D_FF ** -0.5),
        "post_ffn_g": 1.0 + nrm(ks[23], (L, D_MODEL), 0.05),
    }


def reference(x, pre_mix_g, w_in, gate_bias, rel_bias, shift_mu, w0, w2, a0, a2, g2,
              k_k, k_a, r_k, ln_x_w, ln_x_b, proj_a, proj_b, w_out, post_mix_g,
              pre_ffn_g, w_up, w_down, post_ffn_g):
    b, s, _ = x.shape
    for l in range(DEPTH):
        h = rms_norm(x, pre_mix_g[l])
        proj = h @ w_in[l]
        p_att = proj[..., :ATT_COLS]
        p_rwkv = proj[..., ATT_COLS:ATT_COLS + RWKV_COLS]
        p_gate = proj[..., ATT_COLS + RWKV_COLS:] + gate_bias[l]

        q, k, v = jnp.split(p_att, 3, axis=-1)
        shp = (b, s, H_A, HEAD_A)
        y_a = chunk_band_attention(q.reshape(shp), k.reshape(shp), v.reshape(shp), rel_bias[l])
        y_b = rwkv7_time_mix(p_rwkv, shift_mu[l], w0[l], w2[l], a0[l], a2[l], g2[l],
                             k_k[l], k_a[l], r_k[l], ln_x_w[l], ln_x_b[l])

        gate_a = jax.nn.sigmoid(p_gate[..., :D_MODEL])
        gate_b = jax.nn.sigmoid(p_gate[..., D_MODEL:])
        merged = gate_a * (y_a @ proj_a[l]) + gate_b * (y_b @ proj_b[l])
        x = x + rms_norm(merged @ w_out[l], post_mix_g[l])

        hf = rms_norm(x, pre_ffn_g[l])
        u = jnp.square(jax.nn.relu(hf @ w_up[l])) @ w_down[l]
        x = x + rms_norm(u, post_ffn_g[l])
    return x
```

```cpp
#include <hip/hip_runtime.h>
#include <hip/hip_cooperative_groups.h>
#include <cstdio>
#include <cstdint>
namespace cg = cooperative_groups;
namespace pg8 {
#define PG8_LAS __attribute__((address_space(3)))
typedef unsigned short bf16_t;
typedef short bf16x8 __attribute__((ext_vector_type(8)));
typedef float f32x4 __attribute__((ext_vector_type(4)));
typedef unsigned u32x4 __attribute__((ext_vector_type(4)));
constexpr int BM = 256, BK = 64, HALF = 128, HTB = HALF * BK * 2  , STAGE_BYTES = 8 * HTB, NXCD = 8, WGM = 8;

__host__ __device__ __forceinline__ int lds_byte(int r, int c) { const int st = (r >> 4) * 2 + (c >> 5), rr = r & 15, cc = c & 31, ob = rr * 64 + cc * 2; return st * 1024 + (ob ^ (((ob >> 9) & 1) << 5)); }
__host__ __device__ __forceinline__ void stage_rc(int b, int& R, int& C) { const int st = b / 1024, sb = b % 1024, swz = sb ^ (((sb >> 9) & 1) << 5); R = (st >> 1) * 16 + swz / 64; C = (st & 1) * 32 + (swz % 64) / 2; }
__host__ __device__ __forceinline__ int perm32(int rho) { const int n = rho >> 4, i = rho & 15; return 8 * (i >> 2) + 4 * n + (i & 3); }

struct Unit { int pm, pn; };
struct Gemm { const bf16_t* A; const bf16_t* Bt; int M, N, K; };

struct StaticOrder {
    int nM, nN, nwg, G, c;
    __host__ __device__ void init(int M, int N, int G_, int c_) { nM = M / BM; nN = N / BM; nwg = nM * nN; G = G_; c = c_; }
    __host__ __device__ bool next(int i, Unit& u) const {
        const long L = (long)i * G + c; if (L >= nwg) return false;
        int wgid = (int)L; { const int q = nwg / NXCD, r = nwg % NXCD, xcd = wgid % NXCD, off = wgid / NXCD; wgid = (xcd < r ? xcd * (q + 1) : r * (q + 1) + (xcd - r) * q) + off; }
        const int nig = WGM * nN, gid = wgid / nig, fm = gid * WGM, gsz = (nM - fm) < WGM ? (nM - fm) : WGM;
        u.pm = fm + ((wgid % nig) % gsz); u.pn = (wgid % nig) / gsz; return true;
    }
    __device__ __forceinline__ void a_ready(const Unit&) const {}
    __device__ __forceinline__ void done(const Unit&) const {}
};

typedef float f32x2 __attribute__((ext_vector_type(2)));
typedef __bf16 bf16x2_t __attribute__((ext_vector_type(2)));
__device__ __forceinline__ unsigned cvt_pk_bf16(float lo, float hi) { f32x2 v = {lo, hi}; bf16x2_t b = __builtin_convertvector(v, bf16x2_t); return __builtin_bit_cast(unsigned, b); }
__device__ __forceinline__ float bflo(unsigned w) { return __uint_as_float(w << 16); }
__device__ __forceinline__ float bfhi(unsigned w) { return __uint_as_float(w & 0xffff0000u); }
__device__ __forceinline__ float sigmoidf_(float x) { return 1.0f / (1.0f + __expf(-x)); }

template <int MODE> struct Epi {
    static constexpr bool PERM = true, AFTER_DRAIN = false;
    bf16_t* o0; bf16_t* o1; bf16_t* o2; float* of; int ldc; const float* bias; const bf16_t* gate; int gcol0; const bf16_t* tmp;
    __device__ __forceinline__ void operator()(const f32x4 (&acc)[2][2][4][2], const Unit& u, int wr, int wc, int fr, int fq) const {
        const int row0 = u.pm * BM + wr * 64 + fr;
        int colt = u.pn * BM; bf16_t* base = o0; int ld = ldc; float sc = 1.f;
        if (MODE == 0) {
            if (u.pn < 2) { base = o0; ld = 512; sc = 0.125f; }
            else if (u.pn < 4) { base = o1; ld = 512; colt -= 512; }
            else { base = o2; ld = 1792; colt -= 1024; }
        }
        const int col0 = colt + wc * 32 + 8 * fq;
        const int gc0 = u.pn * BM + wc * 32 + 8 * fq;
#pragma unroll
        for (int ai = 0; ai < 2; ++ai)
#pragma unroll
            for (int m = 0; m < 4; ++m) {
                const size_t row = (size_t)(row0 + ai * HALF + m * 16);
#pragma unroll
                for (int bj = 0; bj < 2; ++bj) {
                    f32x4 v0 = acc[ai][bj][m][0], v1 = acc[ai][bj][m][1];
                    const int col = col0 + bj * HALF, gc = gc0 + bj * HALF;
                    if (MODE == 5) {
                        float* p = of + row * ld + col; *(f32x4*)p = v0; *(f32x4*)(p + 4) = v1;
                    } else {
                        if (MODE == 0) { v0 = v0 * sc; v1 = v1 * sc; }
                        if (MODE == 2) {
                            const f32x4 b0 = *(const f32x4*)(bias + gc), b1 = *(const f32x4*)(bias + gc + 4);
#pragma unroll
                            for (int e = 0; e < 4; ++e) { v0[e] = sigmoidf_(v0[e] + b0[e]); v1[e] = sigmoidf_(v1[e] + b1[e]); }
                        }
                        if (MODE == 3 || MODE == 4) {
                            const u32x4 g = *(const u32x4*)(gate + row * 2048 + gcol0 + gc);
                            v0[0] *= bflo(g.x); v0[1] *= bfhi(g.x); v0[2] *= bflo(g.y); v0[3] *= bfhi(g.y);
                            v1[0] *= bflo(g.z); v1[1] *= bfhi(g.z); v1[2] *= bflo(g.w); v1[3] *= bfhi(g.w);
                        }
                        if (MODE == 4) {
                            const u32x4 t = *(const u32x4*)(tmp + row * ld + col);
                            v0[0] += bflo(t.x); v0[1] += bfhi(t.x); v0[2] += bflo(t.y); v0[3] += bfhi(t.y);
                            v1[0] += bflo(t.z); v1[1] += bfhi(t.z); v1[2] += bflo(t.w); v1[3] += bfhi(t.w);
                        }
                        if (MODE == 6) {
#pragma unroll
                            for (int e = 0; e < 4; ++e) { float a = fmaxf(v0[e], 0.f), b = fmaxf(v1[e], 0.f); v0[e] = a * a; v1[e] = b * b; }
                        }
                        u32x4 w; w.x = cvt_pk_bf16(v0[0], v0[1]); w.y = cvt_pk_bf16(v0[2], v0[3]); w.z = cvt_pk_bf16(v1[0], v1[1]); w.w = cvt_pk_bf16(v1[2], v1[3]);
                        *(u32x4*)(base + row * ld + col) = w;
                    }
                }
            }
    }
};

template <class Epi, class Sched, bool ALIGN_EPI = false, bool SP2 = false>
__device__ __forceinline__ void gemm_phase(PG8_LAS unsigned char* lds, const Gemm g, const Sched& S, const Epi& E) {
    int tid_ = threadIdx.x; asm volatile("" : "+v"(tid_) :: "memory");
    const int tid = tid_, wid = __builtin_amdgcn_readfirstlane(tid >> 6), lane = tid & 63, wr = wid >> 2, wc = wid & 3, fr = lane & 15, fq = lane >> 4;
    const int K = g.K, nt = K / BK;
    unsigned voffA[2], voffB[2];
#pragma unroll
    for (int i = 0; i < 2; ++i) { int R, C; stage_rc(tid * 16 + i * 8192, R, C); const int Rb = Epi::PERM ? ((R & ~31) + perm32(R & 31)) : R;
        voffA[i] = (unsigned)(R * K + C) * 2u; voffB[i] = (unsigned)(Rb * K + C) * 2u; }
    const size_t kstep = (size_t)(BK * 2);
    const size_t hstep = (size_t)HALF * K * 2;
    const size_t tstep = 2 * hstep;
    const unsigned ldsw = (unsigned)wid * 1024u;
    const int aoff = lds_byte(wr * 64 + fr, fq * 8), boff = lds_byte(wc * 32 + fr, fq * 8);
#define PG8_SA(b, h) (((b) * 2 + (h)) * HTB)
#define PG8_SB(b, h) ((4 + (b) * 2 + (h)) * HTB)
#define PG8_STAGE(bufoff, gbase, voff) do { _Pragma("unroll") for (int _i = 0; _i < 2; ++_i) \
        __builtin_amdgcn_global_load_lds((const unsigned*)((const char*)(gbase) + (voff)[_i]), (PG8_LAS unsigned*)(lds + (bufoff) + ldsw + _i * 8192), 16, 0, 0); } while (0)
#define PG8_LDA(dst, b, h) do { _Pragma("unroll") for (int m = 0; m < 4; ++m) _Pragma("unroll") for (int k = 0; k < 2; ++k) dst[m][k] = *(const PG8_LAS bf16x8*)(lds + PG8_SA(b, h) + aoff + m * 2048 + k * 1024); } while (0)
#define PG8_LDB(dst, b, h) do { _Pragma("unroll") for (int n = 0; n < 2; ++n) _Pragma("unroll") for (int k = 0; k < 2; ++k) dst[n][k] = *(const PG8_LAS bf16x8*)(lds + PG8_SB(b, h) + boff + n * 2048 + k * 1024); } while (0)
#define PG8_MMA(ai, bj, At, Bt) do { __builtin_amdgcn_s_setprio(1); _Pragma("unroll") for (int m = 0; m < 4; ++m) _Pragma("unroll") for (int n = 0; n < 2; ++n) _Pragma("unroll") for (int k = 0; k < 2; ++k) \
        acc[ai][bj][m][n] = __builtin_amdgcn_mfma_f32_16x16x32_bf16(Bt[n][k], At[m][k], acc[ai][bj][m][n], 0, 0, 0); __builtin_amdgcn_s_setprio(0); } while (0)
#define PG8_WAIT_V(n) asm volatile("s_waitcnt vmcnt(" #n ")" ::: "memory")
#define PG8_WAIT_L(n) asm volatile("s_waitcnt lgkmcnt(" #n ")" ::: "memory")
#define PG8_BAR __builtin_amdgcn_s_barrier()
#define PG8_SCHED __builtin_amdgcn_sched_barrier(0)
    Unit cur, nxt; int ui = 0;
    if (!S.next(0, cur)) return;
    f32x4 acc[2][2][4][2];
#pragma unroll
    for (int a = 0; a < 2; ++a)
#pragma unroll
        for (int b = 0; b < 2; ++b)
#pragma unroll
            for (int m = 0; m < 4; ++m)
#pragma unroll
                for (int n = 0; n < 2; ++n) acc[a][b][m][n] = (f32x4){0.f, 0.f, 0.f, 0.f};
    bf16x8 At[4][2], B0[2][2], B1[2][2];
    const char* cA = (const char*)g.A + (size_t)cur.pm * tstep; const char* cB = (const char*)g.Bt + (size_t)cur.pn * tstep;
    S.a_ready(cur);
    if constexpr (SP2) {
        PG8_STAGE(PG8_SB(0, 0), cB, voffB); PG8_STAGE(PG8_SB(0, 1), cB + hstep, voffB); PG8_STAGE(PG8_SA(0, 0), cA, voffA); PG8_STAGE(PG8_SA(0, 1), cA + hstep, voffA);
        if (wr == 1) PG8_BAR;
        PG8_WAIT_V(2); PG8_BAR;
        PG8_STAGE(PG8_SB(1, 0), cB + kstep, voffB); PG8_STAGE(PG8_SA(1, 0), cA + kstep, voffA); PG8_STAGE(PG8_SB(1, 1), cB + hstep + kstep, voffB);
        PG8_WAIT_V(6); PG8_BAR;
    } else {
        PG8_STAGE(PG8_SB(0, 0), cB, voffB); PG8_STAGE(PG8_SA(0, 0), cA, voffA); PG8_STAGE(PG8_SB(0, 1), cB + hstep, voffB); PG8_STAGE(PG8_SA(0, 1), cA + hstep, voffA);
        if (wr == 1) PG8_BAR;
        PG8_WAIT_V(4); PG8_BAR;
        PG8_STAGE(PG8_SB(1, 0), cB + kstep, voffB); PG8_STAGE(PG8_SA(1, 0), cA + kstep, voffA); PG8_STAGE(PG8_SB(1, 1), cB + hstep + kstep, voffB);
        PG8_WAIT_V(6); PG8_BAR;
    }
    for (;;) {
        const bool has_next = S.next(ui + 1, nxt);
        const char* nA = has_next ? (const char*)g.A + (size_t)nxt.pm * tstep : cA; const char* nB = has_next ? (const char*)g.Bt + (size_t)nxt.pn * tstep : cB;
        for (int t = 0; t < nt; t += 2) {
            const bool last = (t == nt - 2);
            const char* a1 = cA + (size_t)(t + 1) * kstep;
            const char* a2 = last ? nA : cA + (size_t)(t + 2) * kstep; const char* b2 = last ? nB : cB + (size_t)(t + 2) * kstep;
            const char* a3 = a2 + kstep; const char* b3 = b2 + kstep;
            if (last && has_next) S.a_ready(nxt);
            if constexpr (SP2) {
            PG8_LDB(B0, 0, 0); PG8_LDB(B1, 0, 1); PG8_SCHED; PG8_LDA(At, 0, 0); PG8_STAGE(PG8_SA(1, 1), a1 + hstep, voffA);
            PG8_WAIT_V(8); PG8_WAIT_L(0); PG8_BAR; PG8_MMA(0, 0, At, B0); PG8_MMA(0, 1, At, B1); PG8_BAR; PG8_SCHED;
            PG8_LDA(At, 0, 1); PG8_STAGE(PG8_SB(0, 0), b2, voffB); PG8_STAGE(PG8_SB(0, 1), b2 + hstep, voffB); PG8_STAGE(PG8_SA(0, 0), a2, voffA);
            PG8_WAIT_V(8); PG8_WAIT_L(0); PG8_BAR; PG8_MMA(1, 0, At, B0); PG8_MMA(1, 1, At, B1); PG8_BAR; PG8_SCHED;
            PG8_LDB(B0, 1, 0); PG8_LDB(B1, 1, 1); PG8_SCHED; PG8_LDA(At, 1, 0); PG8_STAGE(PG8_SA(0, 1), a2 + hstep, voffA);
            PG8_WAIT_V(8); PG8_WAIT_L(0); PG8_BAR; PG8_MMA(0, 0, At, B0); PG8_MMA(0, 1, At, B1); PG8_BAR; PG8_SCHED;
            PG8_LDA(At, 1, 1); PG8_STAGE(PG8_SB(1, 0), b3, voffB); PG8_STAGE(PG8_SB(1, 1), b3 + hstep, voffB); PG8_STAGE(PG8_SA(1, 0), a3, voffA);
            PG8_WAIT_V(8); PG8_WAIT_L(0); PG8_BAR; PG8_MMA(1, 0, At, B0); PG8_MMA(1, 1, At, B1); PG8_BAR; PG8_SCHED;
            } else {
            PG8_LDB(B0, 0, 0); PG8_SCHED; PG8_LDA(At, 0, 0); PG8_STAGE(PG8_SA(1, 1), a1 + hstep, voffA);
            PG8_WAIT_L(8); PG8_BAR; PG8_WAIT_L(0); PG8_MMA(0, 0, At, B0); PG8_BAR; PG8_SCHED;
            PG8_LDB(B1, 0, 1); PG8_STAGE(PG8_SB(0, 0), b2, voffB);
            PG8_BAR; PG8_WAIT_L(0); PG8_MMA(0, 1, At, B1); PG8_BAR;
            PG8_LDA(At, 0, 1); PG8_STAGE(PG8_SA(0, 0), a2, voffA);
            PG8_BAR; PG8_WAIT_L(0); PG8_MMA(1, 0, At, B0); PG8_BAR; PG8_SCHED;
            PG8_STAGE(PG8_SB(0, 1), b2 + hstep, voffB);
            PG8_WAIT_V(6); PG8_BAR; PG8_MMA(1, 1, At, B1); PG8_BAR;
            PG8_LDB(B0, 1, 0); PG8_SCHED; PG8_LDA(At, 1, 0); PG8_STAGE(PG8_SA(0, 1), a2 + hstep, voffA);
            PG8_WAIT_L(8); PG8_BAR; PG8_WAIT_L(0); PG8_MMA(0, 0, At, B0); PG8_BAR; PG8_SCHED;
            PG8_LDB(B1, 1, 1); PG8_STAGE(PG8_SB(1, 0), b3, voffB);
            PG8_BAR; PG8_WAIT_L(0); PG8_MMA(0, 1, At, B1); PG8_BAR;
            PG8_LDA(At, 1, 1); PG8_STAGE(PG8_SA(1, 0), a3, voffA);
            PG8_BAR; PG8_WAIT_L(0); PG8_MMA(1, 0, At, B0); PG8_BAR; PG8_SCHED;
            PG8_STAGE(PG8_SB(1, 1), b3 + hstep, voffB);
            PG8_WAIT_V(6); PG8_BAR; PG8_MMA(1, 1, At, B1); PG8_BAR;
            }
        }
        if constexpr (ALIGN_EPI) { if (wr == 0) PG8_BAR; }
        if constexpr (!Epi::AFTER_DRAIN) { E(acc, cur, wr, wc, fr, fq); S.done(cur); }
        if (!has_next) break;
#pragma unroll
        for (int a = 0; a < 2; ++a)
#pragma unroll
            for (int b = 0; b < 2; ++b)
#pragma unroll
                for (int m = 0; m < 4; ++m)
#pragma unroll
                    for (int n = 0; n < 2; ++n) acc[a][b][m][n] = (f32x4){0.f, 0.f, 0.f, 0.f};
        cur = nxt; cA = nA; cB = nB; ++ui;
        if constexpr (ALIGN_EPI) { if (wr == 1) PG8_BAR; }
    }
    PG8_WAIT_V(0);
    if constexpr (!ALIGN_EPI) { if (wr == 0) PG8_BAR; }
    PG8_BAR;
    if constexpr (Epi::AFTER_DRAIN) { E.fused(acc, cur, wr, wc, fr, fq, lds, wid, lane); S.done(cur); }
#undef PG8_SA
#undef PG8_SB
#undef PG8_STAGE
#undef PG8_LDA
#undef PG8_LDB
#undef PG8_MMA
#undef PG8_WAIT_V
#undef PG8_WAIT_L
#undef PG8_BAR
#undef PG8_SCHED
}
}

#ifndef PG8_SP2
#define PG8_SP2 true
#endif
#ifndef PG8_ALIGN
#define PG8_ALIGN true
#endif

#define DI __device__ __forceinline__
#define LAS __attribute__((address_space(3)))
typedef unsigned short bf16;
typedef float f32x4 __attribute__((ext_vector_type(4)));
typedef float f32x16 __attribute__((ext_vector_type(16)));
typedef short bf16x8 __attribute__((ext_vector_type(8)));
typedef unsigned u32x4 __attribute__((ext_vector_type(4)));
typedef unsigned u32x2 __attribute__((ext_vector_type(2)));
using pg8::cvt_pk_bf16; using pg8::bflo; using pg8::bfhi; using pg8::sigmoidf_;

constexpr int SEQ = 8192, NB = 2, M = NB * SEQ, D = 1024, FF = 4096;
constexpr int NWAVES = 8, NTHR = 512;
constexpr int LDS_BYTES = 136 * 1024;
constexpr int MISC_OFF = 128 * 1024;
constexpr float RMS_EPS = 1e-6f, GN_EPS = 64e-5f;
#ifndef SEQ_SCAN
#define SEQ_SCAN 0
#endif

constexpr size_t KiB = 1024, MiB = 1u << 20;
constexpr size_t W_A = 1 * MiB;
constexpr size_t W_V = W_A + 2816 * 1024 * 2;
constexpr size_t W_G = W_V + 512 * 1024 * 2;
constexpr size_t W_PA = W_G + 2048 * 1024 * 2;
constexpr size_t W_PB = W_PA + 1 * MiB;
constexpr size_t W_O = W_PB + 1 * MiB;
constexpr size_t W_UP = W_O + 2 * MiB;
constexpr size_t W_DN = W_UP + 8 * MiB;
constexpr size_t W_L2 = W_DN + 8 * MiB;
constexpr size_t W_LA = W_L2 + 64 * KiB;
constexpr size_t W_LG = W_LA + 64 * KiB;
constexpr size_t WS_XN = 32 * MiB;
constexpr size_t WS_Q = 64 * MiB, WS_K = 80 * MiB, WS_VT = 96 * MiB;
constexpr size_t WS_AA = 112 * MiB, WS_BB = 128 * MiB, WS_K2 = 144 * MiB, WS_WR = 160 * MiB;
constexpr size_t WS_WW = 176 * MiB;
constexpr size_t WS_VV = 208 * MiB, WS_GG = 224 * MiB;
constexpr size_t WS_SC = 240 * MiB;
constexpr size_t WS_SCH = WS_K;
constexpr size_t WS_YB = WS_VT;
constexpr size_t WS_G = 112 * MiB;
constexpr size_t WS_TMP = 176 * MiB;
constexpr size_t WS_MG = 208 * MiB;
constexpr size_t WS_Z = 32 * MiB;
constexpr size_t WS_HF = 96 * MiB;
constexpr size_t WS_H = 128 * MiB;
static_assert(W_LG + 128 * KiB <= WS_XN, "weights fit below XN");
constexpr size_t O_MT = 0, O_SL = 16 * MiB, O_YI = 32 * MiB, O_YL = 48 * MiB;

struct Params { const float* in[24]; float* out; unsigned char* ws; };
enum { I_X = 0, I_PREG, I_WIN, I_GBIAS, I_RELB, I_MU, I_W0, I_W2, I_A0, I_A2, I_G2, I_KK, I_KA, I_RK, I_LNW, I_LNB, I_PA, I_PB, I_WO, I_POSTG, I_PREF, I_WUP, I_WDN, I_POSTF };

DI float wave_sum(float v) {
#pragma unroll
    for (int o = 1; o < 64; o <<= 1) v += __shfl_xor(v, o);
    return v;
}
DI float quad_sum(float x) {
    x += __builtin_bit_cast(float, __builtin_amdgcn_update_dpp(0, __builtin_bit_cast(int, x), 0xB1, 0xF, 0xF, true));
    x += __builtin_bit_cast(float, __builtin_amdgcn_update_dpp(0, __builtin_bit_cast(int, x), 0x4E, 0xF, 0xF, true));
    return x;
}
DI float row16_sum(float x) {
    x += __shfl_xor(x, 1); x += __shfl_xor(x, 2); x += __shfl_xor(x, 4); x += __shfl_xor(x, 8);
    return x;
}

DI void p0_transpose_item(const float* W, int K, int ldw, int src_c0, int ncols, bf16* WT, int dst_r0, LAS float* scr, int item, int lane) {
    const int nblk = ncols / 32, kb = item / nblk, nb = item % nblk, k0 = 64 * kb, n0 = 32 * nb;
#pragma unroll 8
    for (int i = 0; i < 32; ++i) { const int kk = 2 * i + (lane >> 5); scr[kk * 33 + (lane & 31)] = W[(size_t)(k0 + kk) * ldw + src_c0 + n0 + (lane & 31)]; }
    asm volatile("s_waitcnt lgkmcnt(0)" ::: "memory");
    const int c = lane & 7;
#pragma unroll
    for (int j = 0; j < 4; ++j) { const int n = (lane >> 3) + 8 * j; const LAS float* s = scr + (8 * c) * 33 + n;
        u32x4 o; o.x = cvt_pk_bf16(s[0 * 33], s[1 * 33]); o.y = cvt_pk_bf16(s[2 * 33], s[3 * 33]); o.z = cvt_pk_bf16(s[4 * 33], s[5 * 33]); o.w = cvt_pk_bf16(s[6 * 33], s[7 * 33]);
        *(u32x4*)(WT + (size_t)(dst_r0 + n0 + n) * K + k0 + 8 * c) = o; }
    asm volatile("s_waitcnt lgkmcnt(0)" ::: "memory");
}
DI void rms_row_to_bf16(const float* xrow, const float* g, bf16* orow, int lane) {
    const f32x4* xr = (const f32x4*)xrow + lane; const f32x4* gr = (const f32x4*)g + lane;
    f32x4 v[4]; float s = 0.f;
#pragma unroll
    for (int j = 0; j < 4; ++j) { v[j] = xr[64 * j]; s += (v[j].x * v[j].x + v[j].y * v[j].y) + (v[j].z * v[j].z + v[j].w * v[j].w); }
    const float rs = rsqrtf(wave_sum(s) * (1.f / D) + RMS_EPS);
    u32x2* o8 = (u32x2*)orow + lane;
#pragma unroll
    for (int j = 0; j < 4; ++j) { const f32x4 gg = gr[64 * j]; u32x2 w; w.x = cvt_pk_bf16(v[j].x * rs * gg.x, v[j].y * rs * gg.y); w.y = cvt_pk_bf16(v[j].z * rs * gg.z, v[j].w * rs * gg.w); o8[64 * j] = w; }
}
DI void phase0(const Params& p, LAS unsigned char* lds, int wave, int lane) {
    LAS float* scr = (LAS float*)(lds + wave * 16384);
    unsigned char* ws = p.ws;
    const int gw = blockIdx.x * NWAVES + wave, NGW = gridDim.x * NWAVES;
    constexpr int IT_QK = 16 * 32, IT_V = 16 * 16, IT_R = 16 * 56, IT_G = 16 * 64, IT_PA = 8 * 32, IT_PB = 8 * 32, IT_O = 16 * 32, IT_UP = 16 * 128, IT_DN = 64 * 32, IT_L2 = 16, IT_LA = 16, IT_LG = 2 * 16;
    constexpr int NITEMS = IT_QK + IT_V + IT_R + IT_G + IT_PA + IT_PB + IT_O + IT_UP + IT_DN + IT_L2 + IT_LA + IT_LG;
    for (int it = gw; it < NITEMS; it += NGW) {
        int r = it;
        if (r < IT_QK) { p0_transpose_item(p.in[I_WIN], 1024, 5376, 0, 1024, (bf16*)(ws + W_A), 0, scr, r, lane); continue; } r -= IT_QK;
        if (r < IT_V) { p0_transpose_item(p.in[I_WIN], 1024, 5376, 1024, 512, (bf16*)(ws + W_V), 0, scr, r, lane); continue; } r -= IT_V;
        if (r < IT_R) { p0_transpose_item(p.in[I_WIN], 1024, 5376, 1536, 1792, (bf16*)(ws + W_A), 1024, scr, r, lane); continue; } r -= IT_R;
        if (r < IT_G) { p0_transpose_item(p.in[I_WIN], 1024, 5376, 3328, 2048, (bf16*)(ws + W_G), 0, scr, r, lane); continue; } r -= IT_G;
        if (r < IT_PA) { p0_transpose_item(p.in[I_PA], 512, 1024, 0, 1024, (bf16*)(ws + W_PA), 0, scr, r, lane); continue; } r -= IT_PA;
        if (r < IT_PB) { p0_transpose_item(p.in[I_PB], 512, 1024, 0, 1024, (bf16*)(ws + W_PB), 0, scr, r, lane); continue; } r -= IT_PB;
        if (r < IT_O) { p0_transpose_item(p.in[I_WO], 1024, 1024, 0, 1024, (bf16*)(ws + W_O), 0, scr, r, lane); continue; } r -= IT_O;
        if (r < IT_UP) { p0_transpose_item(p.in[I_WUP], 1024, 4096, 0, 4096, (bf16*)(ws + W_UP), 0, scr, r, lane); continue; } r -= IT_UP;
        if (r < IT_DN) { p0_transpose_item(p.in[I_WDN], 4096, 1024, 0, 1024, (bf16*)(ws + W_DN), 0, scr, r, lane); continue; } r -= IT_DN;
        if (r < IT_L2) { p0_transpose_item(p.in[I_W2], 64, 512, 0, 512, (bf16*)(ws + W_L2), 0, scr, r, lane); continue; } r -= IT_L2;
        if (r < IT_LA) { p0_transpose_item(p.in[I_A2], 64, 512, 0, 512, (bf16*)(ws + W_LA), 0, scr, r, lane); continue; } r -= IT_LA;
        p0_transpose_item(p.in[I_G2], 128, 512, 0, 512, (bf16*)(ws + W_LG), 0, scr, r, lane);
    }
    bf16* XN = (bf16*)(ws + WS_XN);
    for (int m = gw; m < M; m += NGW) rms_row_to_bf16(p.in[I_X] + (size_t)m * D, p.in[I_PREG], XN + (size_t)m * D, lane);
}

DI float tanhf_(float x) { const float e = __expf(-2.f * fabsf(x)); const float t = (1.f - e) / (1.f + e); return x < 0.f ? -t : t; }
DI void phase2(const Params& p, LAS unsigned char* lds, int wave, int lane) {
    unsigned char* ws = p.ws;
    const bf16* Rraw = (const bf16*)p.out;
    const float* mu = p.in[I_MU];
    constexpr int APITCH = 264;
    LAS bf16* At = (LAS bf16*)lds;
    const bf16* w2t = (const bf16*)(ws + W_L2); const bf16* a2t = (const bf16*)(ws + W_LA); const bf16* g2t = (const bf16*)(ws + W_LG);
    bf16* AA = (bf16*)(ws + WS_AA); bf16* BB = (bf16*)(ws + WS_BB); bf16* K2 = (bf16*)(ws + WS_K2); bf16* WR = (bf16*)(ws + WS_WR);
    float* WW = (float*)(ws + WS_WW); bf16* VV = (bf16*)(ws + WS_VV); bf16* GG = (bf16*)(ws + WS_GG); float* SC = (float*)(ws + WS_SC);
    const int tid = wave * 64 + lane, h = wave, c = lane & 15, q = lane >> 4;
    for (int tt = blockIdx.x; tt < M / 16; tt += gridDim.x) {
        const int m0 = tt * 16;
        __syncthreads();
#pragma unroll
        for (int i = 0; i < 8; ++i) {
            const int e = tid + NTHR * i, tk = e >> 8, ci = e & 255, m = m0 + tk, col = 1536 + ci;
            const float cur = bflo((unsigned)Rraw[(size_t)m * 1792 + col]);
            const float prv = (m & (SEQ - 1)) ? bflo((unsigned)Rraw[(size_t)(m - 1) * 1792 + col]) : 0.f;
            float x = cur + (prv - cur) * mu[col];
            if (ci < 64) x = tanhf_(x); else if (ci >= 128) x = sigmoidf_(x);
            At[tk * APITCH + ci] = (bf16)(cvt_pk_bf16(x, 0.f) & 0xffffu);
        }
        __syncthreads();
        f32x4 accw[4], acca[4], accg[4];
#pragma unroll
        for (int nt = 0; nt < 4; ++nt) { accw[nt] = (f32x4){0.f, 0.f, 0.f, 0.f}; acca[nt] = accw[nt]; accg[nt] = accw[nt]; }
        const LAS bf16* arow = At + (lane & 15) * APITCH + 8 * q;
#pragma unroll
        for (int ks = 0; ks < 2; ++ks) {
            const bf16x8 aw = *(const LAS bf16x8*)(arow + 32 * ks), aa_ = *(const LAS bf16x8*)(arow + 64 + 32 * ks);
#pragma unroll
            for (int nt = 0; nt < 4; ++nt) {
                const size_t wrow = (size_t)(h * 64 + 16 * nt + c);
                const bf16x8 bw = *(const bf16x8*)(w2t + wrow * 64 + 32 * ks + 8 * q), ba = *(const bf16x8*)(a2t + wrow * 64 + 32 * ks + 8 * q);
                accw[nt] = __builtin_amdgcn_mfma_f32_16x16x32_bf16(aw, bw, accw[nt], 0, 0, 0);
                acca[nt] = __builtin_amdgcn_mfma_f32_16x16x32_bf16(aa_, ba, acca[nt], 0, 0, 0);
            }
        }
#pragma unroll
        for (int ks = 0; ks < 4; ++ks) {
            const bf16x8 ag = *(const LAS bf16x8*)(arow + 128 + 32 * ks);
#pragma unroll
            for (int nt = 0; nt < 4; ++nt) {
                const bf16x8 bg = *(const bf16x8*)(g2t + (size_t)(h * 64 + 16 * nt + c) * 128 + 32 * ks + 8 * q);
                accg[nt] = __builtin_amdgcn_mfma_f32_16x16x32_bf16(ag, bg, accg[nt], 0, 0, 0);
            }
        }
#pragma unroll
        for (int rp = 0; rp < 4; ++rp) {
            const int m = m0 + 4 * q + rp; const bool has_prev = (m & (SEQ - 1)) != 0;
            const bf16* rc = Rraw + (size_t)m * 1792; const bf16* rpv = rc - 1792;
            float kkr[4], av[4], wv[4], k2v[4], rv[4], vv[4];
            float ss = 0.f, sbr = 0.f, skr = 0.f, sbo = 0.f;
#pragma unroll
            for (int nt = 0; nt < 4; ++nt) {
                const int col = h * 64 + 16 * nt + c;
                float r_ = bflo((unsigned)rc[col]), k_ = bflo((unsigned)rc[512 + col]), v_ = bflo((unsigned)rc[1024 + col]);
                const float rp_ = has_prev ? bflo((unsigned)rpv[col]) : 0.f, kp_ = has_prev ? bflo((unsigned)rpv[512 + col]) : 0.f, vp_ = has_prev ? bflo((unsigned)rpv[1024 + col]) : 0.f;
                r_ += (rp_ - r_) * mu[col]; k_ += (kp_ - k_) * mu[512 + col]; v_ += (vp_ - v_) * mu[1024 + col];
                const float a = sigmoidf_(acca[nt][rp] + p.in[I_A0][col]);
                const float x = accw[nt][rp] + p.in[I_W0][col];
                const float sp = fmaxf(-x, 0.f) + log1pf(__expf(-fabsf(x)));
                const float w = __expf(-__expf(-sp - 0.5f));
                const float kr_ = k_ * p.in[I_KK][col];
                const float k2 = k_ * (1.f + (a - 1.f) * p.in[I_KA][col]);
                kkr[nt] = kr_; av[nt] = a; wv[nt] = w; k2v[nt] = k2; rv[nt] = r_; vv[nt] = v_;
                ss += kr_ * kr_; sbr += kr_ * a * r_; skr += k2 * r_; sbo += r_ * k2 * p.in[I_RK][col];
            }
            ss = row16_sum(ss); sbr = row16_sum(sbr); skr = row16_sum(skr); sbo = row16_sum(sbo);
            const float inv = 1.f / fmaxf(sqrtf(ss), 1e-12f);
#pragma unroll
            for (int nt = 0; nt < 4; ++nt) {
                const size_t o = (size_t)m * 512 + h * 64 + 16 * nt + c;
                const float kk = kkr[nt] * inv;
                AA[o] = (bf16)(cvt_pk_bf16(-kk, 0.f) & 0xffffu);
                BB[o] = (bf16)(cvt_pk_bf16(kk * av[nt], 0.f) & 0xffffu);
                K2[o] = (bf16)(cvt_pk_bf16(k2v[nt], 0.f) & 0xffffu);
                WR[o] = (bf16)(cvt_pk_bf16(wv[nt] * rv[nt], 0.f) & 0xffffu);
                WW[o] = wv[nt];
                VV[o] = (bf16)(cvt_pk_bf16(vv[nt], 0.f) & 0xffffu);
                GG[o] = (bf16)(cvt_pk_bf16(accg[nt][rp], 0.f) & 0xffffu);
            }
            if (c == 0) *(f32x4*)(SC + ((size_t)m * 8 + h) * 4) = (f32x4){sbr * inv, skr, sbo, 0.f};
        }
    }
    __syncthreads();
}

#define MFMA32(a, b, c) __builtin_amdgcn_mfma_f32_32x32x16_bf16((a), (b), (c), 0, 0, 0)
DI int crow(int r, int hh) { return (r & 3) + 8 * (r >> 2) + 4 * hh; }
DI void attn_task(int task, const bf16* Q, const bf16* Kb, const bf16* Vt, bf16* yA, const LAS float* biasL, int lane) {
    const int half = task & 1, h = (task >> 1) & 7, n = (task >> 4) & 127, b = task >> 11;
    const int c = lane & 31, hh = lane >> 5;
    const int qi = 32 * half + c;
    const size_t mq = (size_t)b * SEQ + 64 * n + qi;
    bf16x8 qf[4];
#pragma unroll
    for (int ks = 0; ks < 4; ++ks) qf[ks] = *(const bf16x8*)(Q + mq * 512 + h * 64 + 16 * ks + 8 * hh);
    f32x16 o0, o1;
#pragma unroll
    for (int r = 0; r < 16; ++r) { o0[r] = 0.f; o1[r] = 0.f; }
    float mrun = -1e30f, l = 0.f;
    const LAS float* bl = biasL + h * 320;
    const int kt_min = n >= 8 ? 0 : 2 * (8 - n);
    for (int kt = kt_min; kt < 18; ++kt) {
        const size_t mk0 = (size_t)b * SEQ + 64 * (n - 8) + 32 * kt;
        f32x16 s;
#pragma unroll
        for (int r = 0; r < 16; ++r) s[r] = 0.f;
#pragma unroll
        for (int ks = 0; ks < 4; ++ks) { const bf16x8 kf = *(const bf16x8*)(Kb + (mk0 + c) * 512 + h * 64 + 16 * ks + 8 * hh); s = MFMA32(kf, qf[ks], s); }
        float mx = -1e30f;
#pragma unroll
        for (int r = 0; r < 16; ++r) {
            int dist = qi + 512 - (32 * kt + crow(r, hh));
            dist = dist < -63 ? -63 : (dist > 256 ? 256 : dist);
            s[r] += bl[dist + 63];
            mx = fmaxf(mx, s[r]);
        }
        mx = fmaxf(mx, __shfl_xor(mx, 32));
        const float mnew = fmaxf(mrun, mx), sc = __expf(mrun - mnew);
        float ps = 0.f;
#pragma unroll
        for (int r = 0; r < 16; ++r) { s[r] = __expf(s[r] - mnew); ps += s[r]; }
        ps += __shfl_xor(ps, 32);
        l = l * sc + ps; mrun = mnew;
#pragma unroll
        for (int r = 0; r < 16; ++r) { o0[r] *= sc; o1[r] *= sc; }
        bf16x8 pb[2];
#pragma unroll
        for (int s2 = 0; s2 < 2; ++s2) {
            u32x4 w; w.x = cvt_pk_bf16(s[8 * s2 + 0], s[8 * s2 + 1]); w.y = cvt_pk_bf16(s[8 * s2 + 2], s[8 * s2 + 3]);
            w.z = cvt_pk_bf16(s[8 * s2 + 4], s[8 * s2 + 5]); w.w = cvt_pk_bf16(s[8 * s2 + 6], s[8 * s2 + 7]);
            pb[s2] = __builtin_bit_cast(bf16x8, w);
        }
#pragma unroll
        for (int dt = 0; dt < 2; ++dt) {
            const bf16* vrow = Vt + (size_t)(h * 64 + 32 * dt + c) * M + mk0 + 4 * hh;
#pragma unroll
            for (int s2 = 0; s2 < 2; ++s2) {
                const u32x2 lo = *(const u32x2*)(vrow + 16 * s2), hi = *(const u32x2*)(vrow + 16 * s2 + 8);
                const u32x4 w = {lo.x, lo.y, hi.x, hi.y};
                if (dt == 0) o0 = MFMA32(__builtin_bit_cast(bf16x8, w), pb[s2], o0); else o1 = MFMA32(__builtin_bit_cast(bf16x8, w), pb[s2], o1);
            }
        }
    }
    const float inv = 1.f / l;
    bf16* orow = yA + mq * 512 + h * 64;
#pragma unroll
    for (int r = 0; r < 16; ++r) {
        orow[crow(r, hh)] = (bf16)(cvt_pk_bf16(o0[r] * inv, 0.f) & 0xffffu);
        orow[32 + crow(r, hh)] = (bf16)(cvt_pk_bf16(o1[r] * inv, 0.f) & 0xffffu);
    }
}

template <int TYPE>
DI void scan_local(int chunk, const unsigned char* ws, unsigned char* ob, int lane) {
    const bf16* AA = (const bf16*)(ws + WS_AA); const bf16* BB = (const bf16*)(ws + WS_BB); const bf16* K2 = (const bf16*)(ws + WS_K2); const bf16* WR = (const bf16*)(ws + WS_WR);
    const float* WW = (const float*)(ws + WS_WW); const bf16* VV = (const bf16*)(ws + WS_VV); const float* SC = (const float*)(ws + WS_SC);
    const int bh = chunk >> 7, b = bh >> 3, h = bh & 7, cc = chunk & 127;
    const int l4 = lane & 3, rg = lane >> 2;
    const size_t m0 = (size_t)b * SEQ + 64 * cc;
    const int colb = h * 64 + 16 * l4;
    float s[4][16];
#pragma unroll
    for (int rr = 0; rr < 4; ++rr)
#pragma unroll
        for (int jj = 0; jj < 16; ++jj) s[rr][jj] = (TYPE == 0 && (16 * l4 + jj == 4 * rg + rr)) ? 1.f : 0.f;
    bf16* Yo = (bf16*)(ob + (TYPE == 0 ? O_YI : O_YL)) + (size_t)chunk * 4096;
    u32x4 raa0, raa1, rbb0, rbb1, rk20 = {0, 0, 0, 0}, rk21 = {0, 0, 0, 0}, rwr0, rwr1; f32x4 rw0, rw1, rw2, rw3, rsc; u32x2 rv = {0, 0};
    const unsigned off0 = (unsigned)((m0 * 512 + colb) * 2), voff0 = (unsigned)((m0 * 512 + h * 64 + 4 * rg) * 2), soff0 = (unsigned)((m0 * 8 + h) * 16);
#define SCAN_LOAD1(tt) do { const unsigned o_ = off0 + (unsigned)(tt) * 1024u; \
        raa0 = *(const u32x4*)((const char*)AA + o_); raa1 = *(const u32x4*)((const char*)AA + o_ + 16); rwr0 = *(const u32x4*)((const char*)WR + o_); rwr1 = *(const u32x4*)((const char*)WR + o_ + 16); \
        rsc = *(const f32x4*)((const char*)SC + soff0 + (unsigned)(tt) * 128u); \
        if (TYPE == 1) { rv = *(const u32x2*)((const char*)VV + voff0 + (unsigned)(tt) * 1024u); } } while (0)
#define SCAN_LOAD2(tt) do { const unsigned o_ = off0 + (unsigned)(tt) * 1024u; \
        rbb0 = *(const u32x4*)((const char*)BB + o_); rbb1 = *(const u32x4*)((const char*)BB + o_ + 16); \
        if (TYPE == 1) { rk20 = *(const u32x4*)((const char*)K2 + o_); rk21 = *(const u32x4*)((const char*)K2 + o_ + 16); } } while (0)
#define SCAN_LOAD3(tt) do { const unsigned o_ = 2u * (off0 + (unsigned)(tt) * 1024u); \
        rw0 = *(const f32x4*)((const char*)WW + o_); rw1 = *(const f32x4*)((const char*)WW + o_ + 16); rw2 = *(const f32x4*)((const char*)WW + o_ + 32); rw3 = *(const f32x4*)((const char*)WW + o_ + 48); } while (0)
    SCAN_LOAD1(0); SCAN_LOAD2(0); SCAN_LOAD3(0);
    for (int t = 0; t < 64; ++t) {
        const int mn = t < 63 ? t + 1 : 63;
        float aa[16], wr[16];
#pragma unroll
        for (int e = 0; e < 4; ++e) { aa[2 * e] = bflo(raa0[e]); aa[2 * e + 1] = bfhi(raa0[e]); aa[8 + 2 * e] = bflo(raa1[e]); aa[8 + 2 * e + 1] = bfhi(raa1[e]);
                                      wr[2 * e] = bflo(rwr0[e]); wr[2 * e + 1] = bfhi(rwr0[e]); wr[8 + 2 * e] = bflo(rwr1[e]); wr[8 + 2 * e + 1] = bfhi(rwr1[e]); }
        const float br = rsc.x, kr = rsc.y;
        float vr[4] = {0.f, 0.f, 0.f, 0.f};
        if (TYPE == 1) { vr[0] = bflo(rv.x); vr[1] = bfhi(rv.x); vr[2] = bflo(rv.y); vr[3] = bfhi(rv.y); }
        __builtin_amdgcn_sched_barrier(0);
        SCAN_LOAD1(mn);
        __builtin_amdgcn_sched_barrier(0);
        float sa[4], yv[4];
#pragma unroll
        for (int rr = 0; rr < 4; ++rr) {
            float p1 = 0.f, p1b = 0.f, p2 = 0.f, p2b = 0.f;
#pragma unroll
            for (int jj = 0; jj < 16; jj += 2) { p1 = fmaf(s[rr][jj], aa[jj], p1); p1b = fmaf(s[rr][jj + 1], aa[jj + 1], p1b); p2 = fmaf(s[rr][jj], wr[jj], p2); p2b = fmaf(s[rr][jj + 1], wr[jj + 1], p2b); }
            sa[rr] = quad_sum(p1 + p1b);
            const float yp = quad_sum(p2 + p2b);
            yv[rr] = yp + sa[rr] * br + (TYPE == 1 ? vr[rr] * kr : 0.f);
        }
        if (l4 == 0) { u32x2 w; w.x = cvt_pk_bf16(yv[0], yv[1]); w.y = cvt_pk_bf16(yv[2], yv[3]); *(u32x2*)(Yo + t * 64 + 4 * rg) = w; }
        float bb[16], k2[16];
#pragma unroll
        for (int e = 0; e < 4; ++e) { bb[2 * e] = bflo(rbb0[e]); bb[2 * e + 1] = bfhi(rbb0[e]); bb[8 + 2 * e] = bflo(rbb1[e]); bb[8 + 2 * e + 1] = bfhi(rbb1[e]);
                                      k2[2 * e] = bflo(rk20[e]); k2[2 * e + 1] = bfhi(rk20[e]); k2[8 + 2 * e] = bflo(rk21[e]); k2[8 + 2 * e + 1] = bfhi(rk21[e]); }
        __builtin_amdgcn_sched_barrier(0);
        SCAN_LOAD2(mn);
        __builtin_amdgcn_sched_barrier(0);
        {
            float wv[16];
#pragma unroll
            for (int e = 0; e < 4; ++e) { wv[e] = rw0[e]; wv[4 + e] = rw1[e]; wv[8 + e] = rw2[e]; wv[12 + e] = rw3[e]; }
            if (TYPE == 1) {
#pragma unroll
                for (int rr = 0; rr < 4; ++rr)
#pragma unroll
                    for (int jj = 0; jj < 16; ++jj) s[rr][jj] = fmaf(s[rr][jj], wv[jj], fmaf(sa[rr], bb[jj], vr[rr] * k2[jj]));
            } else {
#pragma unroll
                for (int rr = 0; rr < 4; ++rr)
#pragma unroll
                    for (int jj = 0; jj < 16; ++jj) s[rr][jj] = fmaf(s[rr][jj], wv[jj], sa[rr] * bb[jj]);
            }
        }
        __builtin_amdgcn_sched_barrier(0);
        SCAN_LOAD3(mn);
        __builtin_amdgcn_sched_barrier(0);
    }
#undef SCAN_LOAD1
#undef SCAN_LOAD2
#undef SCAN_LOAD3
    if (TYPE == 0) {
        bf16* Mt = (bf16*)(ob + O_MT) + (size_t)chunk * 4096;
#pragma unroll
        for (int jj = 0; jj < 16; ++jj) { u32x2 w; w.x = cvt_pk_bf16(s[0][jj], s[1][jj]); w.y = cvt_pk_bf16(s[2][jj], s[3][jj]); *(u32x2*)(Mt + (16 * l4 + jj) * 64 + 4 * rg) = w; }
    } else {
        bf16* Sl = (bf16*)(ob + O_SL) + (size_t)chunk * 4096;
#pragma unroll
        for (int rr = 0; rr < 4; ++rr) {
            u32x4 w0, w1;
#pragma unroll
            for (int e = 0; e < 4; ++e) { w0[e] = cvt_pk_bf16(s[rr][2 * e], s[rr][2 * e + 1]); w1[e] = cvt_pk_bf16(s[rr][8 + 2 * e], s[rr][8 + 2 * e + 1]); }
            *(u32x4*)(Sl + (4 * rg + rr) * 64 + 16 * l4) = w0; *(u32x4*)(Sl + (4 * rg + rr) * 64 + 16 * l4 + 8) = w1;
        }
    }
}

#define MFMA16(a, b, c) __builtin_amdgcn_mfma_f32_16x16x32_bf16((a), (b), (c), 0, 0, 0)
DI void scan_prop(int task, unsigned char* ws, const unsigned char* ob, LAS bf16* sl, int lane) {
    const int bh = task >> 2, ib = task & 3, c = lane & 15, q = lane >> 4;
    const bf16* MtB = (const bf16*)(ob + O_MT); const bf16* SlB = (const bf16*)(ob + O_SL); bf16* Sch = (bf16*)(ws + WS_SCH);
    f32x4 acc[4];
#pragma unroll
    for (int nt = 0; nt < 4; ++nt) acc[nt] = (f32x4){0.f, 0.f, 0.f, 0.f};
    for (int cc = 0; cc < 128; ++cc) {
        const size_t cb = (size_t)(bh * 128 + cc) * 4096;
#pragma unroll
        for (int nt = 0; nt < 4; ++nt)
#pragma unroll
            for (int rp = 0; rp < 4; ++rp) {
                const bf16 v = (bf16)(cvt_pk_bf16(acc[nt][rp], 0.f) & 0xffffu);
                sl[(4 * q + rp) * 72 + 16 * nt + c] = v;
                Sch[cb + (size_t)(16 * ib + 4 * q + rp) * 64 + 16 * nt + c] = v;
            }
#pragma unroll
        for (int nt = 0; nt < 4; ++nt)
#pragma unroll
            for (int rp = 0; rp < 4; ++rp) acc[nt][rp] = bflo((unsigned)SlB[cb + (size_t)(16 * ib + 4 * q + rp) * 64 + 16 * nt + c]);
#pragma unroll
        for (int ks = 0; ks < 2; ++ks) {
            const bf16x8 a = *(const LAS bf16x8*)(sl + (lane & 15) * 72 + 32 * ks + 8 * q);
#pragma unroll
            for (int nt = 0; nt < 4; ++nt) { const bf16x8 bm = *(const bf16x8*)(MtB + cb + (size_t)(16 * nt + c) * 64 + 32 * ks + 8 * q); acc[nt] = MFMA16(a, bm, acc[nt]); }
        }
    }
}

DI void scan_out(int task, const Params& p, int lane) {
    unsigned char* ws = p.ws; const unsigned char* ob = (const unsigned char*)p.out;
    const int chunk = task >> 2, mt = task & 3, bh = chunk >> 7, b = bh >> 3, h = bh & 7, cc = chunk & 127, c = lane & 15, q = lane >> 4;
    const size_t cb = (size_t)chunk * 4096;
    const bf16* YI = (const bf16*)(ob + O_YI) + cb; const bf16* YL = (const bf16*)(ob + O_YL) + cb; const bf16* Sch = (const bf16*)(ws + WS_SCH) + cb;
    const bf16* VV = (const bf16*)(ws + WS_VV); const bf16* GG = (const bf16*)(ws + WS_GG); const float* SC = (const float*)(ws + WS_SC); bf16* yB = (bf16*)(ws + WS_YB);
    f32x4 acc[4];
#pragma unroll
    for (int nt = 0; nt < 4; ++nt)
#pragma unroll
        for (int rp = 0; rp < 4; ++rp) acc[nt][rp] = bflo((unsigned)YL[(16 * mt + 4 * q + rp) * 64 + 16 * nt + c]);
#pragma unroll
    for (int ks = 0; ks < 2; ++ks) {
        const bf16x8 a = *(const bf16x8*)(YI + (16 * mt + (lane & 15)) * 64 + 32 * ks + 8 * q);
#pragma unroll
        for (int nt = 0; nt < 4; ++nt) { const bf16x8 bs = *(const bf16x8*)(Sch + (16 * nt + c) * 64 + 32 * ks + 8 * q); acc[nt] = MFMA16(a, bs, acc[nt]); }
    }
#pragma unroll
    for (int rp = 0; rp < 4; ++rp) {
        const size_t m = (size_t)b * SEQ + 64 * cc + 16 * mt + 4 * q + rp;
        float sm = (acc[0][rp] + acc[1][rp]) + (acc[2][rp] + acc[3][rp]);
        const float mean = row16_sum(sm) * (1.f / 64.f);
        float sv = 0.f;
#pragma unroll
        for (int nt = 0; nt < 4; ++nt) { const float d = acc[nt][rp] - mean; sv += d * d; }
        const float rstd = rsqrtf(row16_sum(sv) * (1.f / 64.f) + GN_EPS);
        const float bonus = SC[(m * 8 + h) * 4 + 2];
#pragma unroll
        for (int nt = 0; nt < 4; ++nt) {
            const int col = h * 64 + 16 * nt + c;
            const float yn = (acc[nt][rp] - mean) * rstd * p.in[I_LNW][col] + p.in[I_LNB][col];
            const float o = (yn + bonus * bflo((unsigned)VV[m * 512 + col])) * bflo((unsigned)GG[m * 512 + col]);
            yB[m * 512 + col] = (bf16)(cvt_pk_bf16(o, 0.f) & 0xffffu);
        }
    }
}

DI void row_pass1(const float* x, const float* z, const float* g1, const float* g2, float* out, bf16* hf, int lane) {
    f32x4 v[4]; float s = 0.f;
#pragma unroll
    for (int j = 0; j < 4; ++j) { v[j] = ((const f32x4*)z)[lane + 64 * j]; s += (v[j].x * v[j].x + v[j].y * v[j].y) + (v[j].z * v[j].z + v[j].w * v[j].w); }
    const float rs = rsqrtf(wave_sum(s) * (1.f / D) + RMS_EPS);
    float s2 = 0.f;
#pragma unroll
    for (int j = 0; j < 4; ++j) { const f32x4 xx = ((const f32x4*)x)[lane + 64 * j], gg = ((const f32x4*)g1)[lane + 64 * j]; v[j] = xx + v[j] * rs * gg; ((f32x4*)out)[lane + 64 * j] = v[j];
        s2 += (v[j].x * v[j].x + v[j].y * v[j].y) + (v[j].z * v[j].z + v[j].w * v[j].w); }
    const float rs2 = rsqrtf(wave_sum(s2) * (1.f / D) + RMS_EPS);
#pragma unroll
    for (int j = 0; j < 4; ++j) { const f32x4 gg = ((const f32x4*)g2)[lane + 64 * j]; u32x2 w; w.x = cvt_pk_bf16(v[j].x * rs2 * gg.x, v[j].y * rs2 * gg.y); w.y = cvt_pk_bf16(v[j].z * rs2 * gg.z, v[j].w * rs2 * gg.w); ((u32x2*)hf)[lane + 64 * j] = w; }
}
DI void row_pass2(const float* u, const float* g, float* out, int lane) {
    f32x4 v[4]; float s = 0.f;
#pragma unroll
    for (int j = 0; j < 4; ++j) { v[j] = ((const f32x4*)u)[lane + 64 * j]; s += (v[j].x * v[j].x + v[j].y * v[j].y) + (v[j].z * v[j].z + v[j].w * v[j].w); }
    const float rs = rsqrtf(wave_sum(s) * (1.f / D) + RMS_EPS);
#pragma unroll
    for (int j = 0; j < 4; ++j) { const f32x4 xx = ((const f32x4*)out)[lane + 64 * j], gg = ((const f32x4*)g)[lane + 64 * j]; ((f32x4*)out)[lane + 64 * j] = xx + v[j] * rs * gg; }
}

template <int MODE> DI void run_gemm(LAS unsigned char* lds, const bf16* A, const bf16* Bt, int m, int n, int k, const pg8::Epi<MODE>& E) {
    __syncthreads();
    pg8::Gemm g{A, Bt, m, n, k}; pg8::StaticOrder S; S.init(m, n, (int)gridDim.x, (int)blockIdx.x);
    pg8::gemm_phase<pg8::Epi<MODE>, pg8::StaticOrder, PG8_ALIGN, PG8_SP2>(lds, g, S, E);
    __syncthreads();
}

__global__ void __launch_bounds__(NTHR) fwd(Params p) {
    extern __shared__ __attribute__((aligned(16))) unsigned char lds_raw[];
    LAS unsigned char* lds = (LAS unsigned char*)lds_raw;
    cg::grid_group grid = cg::this_grid();
#define PHASE_IDS() int tid = threadIdx.x; asm volatile("" : "+v"(tid) :: "memory"); const int lane = tid & 63, wave = __builtin_amdgcn_readfirstlane(tid >> 6); \
    const int gw = blockIdx.x * NWAVES + wave, NGW = gridDim.x * NWAVES; (void)gw; (void)NGW; (void)lane
    unsigned char* ws = p.ws; unsigned char* ob = (unsigned char*)p.out;

    { PHASE_IDS(); phase0(p, lds, wave, lane); }
    grid.sync();

    { pg8::Epi<0> E{}; E.o0 = (bf16*)(ws + WS_Q); E.o1 = (bf16*)(ws + WS_K); E.o2 = (bf16*)ob; E.ldc = 512;
      run_gemm<0>(lds, (const bf16*)(ws + WS_XN), (const bf16*)(ws + W_A), M, 2816, 1024, E); }
    { pg8::Epi<1> E{}; E.o0 = (bf16*)(ws + WS_VT); E.ldc = M;
      run_gemm<1>(lds, (const bf16*)(ws + W_V), (const bf16*)(ws + WS_XN), 512, M, 1024, E); }
    grid.sync();

    { PHASE_IDS(); phase2(p, lds, wave, lane); }
    grid.sync();

    {
        PHASE_IDS();
        LAS float* biasL = (LAS float*)lds;
        for (int i = tid; i < 8 * 320; i += NTHR) biasL[i] = p.in[I_RELB][i];
        __syncthreads();
        for (int t = gw; t < 4096; t += NGW) attn_task(t, (const bf16*)(ws + WS_Q), (const bf16*)(ws + WS_K), (const bf16*)(ws + WS_VT), (bf16*)(ws + WS_Q), biasL, lane);
        for (int t = gw; t < 4096; t += NGW) { if (t & 1) scan_local<1>(t >> 1, ws, ob, lane); else scan_local<0>(t >> 1, ws, ob, lane); }
    }
    grid.sync();

    { PHASE_IDS(); if (gw < 64) scan_prop(gw, ws, ob, (LAS bf16*)(lds + wave * 2304), lane); }
    grid.sync();

    { PHASE_IDS(); for (int t = gw; t < 8192; t += NGW) scan_out(t, p, lane); }
    { pg8::Epi<2> E{}; E.o0 = (bf16*)(ws + WS_G); E.ldc = 2048; E.bias = p.in[I_GBIAS];
      run_gemm<2>(lds, (const bf16*)(ws + WS_XN), (const bf16*)(ws + W_G), M, 2048, 1024, E); }
    grid.sync();

    { pg8::Epi<3> E{}; E.o0 = (bf16*)(ws + WS_TMP); E.ldc = 1024; E.gate = (const bf16*)(ws + WS_G); E.gcol0 = 0;
      run_gemm<3>(lds, (const bf16*)(ws + WS_Q), (const bf16*)(ws + W_PA), M, 1024, 512, E); }
    { pg8::Epi<4> E{}; E.o0 = (bf16*)(ws + WS_MG); E.ldc = 1024; E.gate = (const bf16*)(ws + WS_G); E.gcol0 = 1024; E.tmp = (const bf16*)(ws + WS_TMP);
      run_gemm<4>(lds, (const bf16*)(ws + WS_YB), (const bf16*)(ws + W_PB), M, 1024, 512, E); }
    grid.sync();

    { pg8::Epi<5> E{}; E.of = (float*)(ws + WS_Z); E.ldc = 1024;
      run_gemm<5>(lds, (const bf16*)(ws + WS_MG), (const bf16*)(ws + W_O), M, 1024, 1024, E); }
    grid.sync();
    { PHASE_IDS(); for (int m = gw; m < M; m += NGW)
        row_pass1(p.in[I_X] + (size_t)m * D, (const float*)(ws + WS_Z) + (size_t)m * D, p.in[I_POSTG], p.in[I_PREF], p.out + (size_t)m * D, (bf16*)(ws + WS_HF) + (size_t)m * D, lane); }
    grid.sync();

    { pg8::Epi<6> E{}; E.o0 = (bf16*)(ws + WS_H); E.ldc = FF;
      run_gemm<6>(lds, (const bf16*)(ws + WS_HF), (const bf16*)(ws + W_UP), M, FF, 1024, E); }
    grid.sync();

    { pg8::Epi<5> E{}; E.of = (float*)(ws + WS_Z); E.ldc = 1024;
      run_gemm<5>(lds, (const bf16*)(ws + WS_H), (const bf16*)(ws + W_DN), M, 1024, FF, E); }
    grid.sync();
    PHASE_IDS(); for (int m = gw; m < M; m += NGW) row_pass2((const float*)(ws + WS_Z) + (size_t)m * D, p.in[I_POSTF], p.out + (size_t)m * D, lane);
}

extern "C" void kernel_launch(void* const* d_in, const int* in_sizes, int n_in, void* d_out, int out_size,
                              void* d_ws, size_t ws_size, hipStream_t stream) {
    static int grid_blocks = 0;
    if (!grid_blocks) {
        int dev = 0, cus = 0, per_cu = 0;
        (void)hipGetDevice(&dev);
        (void)hipDeviceGetAttribute(&cus, hipDeviceAttributeMultiprocessorCount, dev);
        (void)hipFuncSetAttribute((const void*)fwd, hipFuncAttributeMaxDynamicSharedMemorySize, LDS_BYTES);
        (void)hipOccupancyMaxActiveBlocksPerMultiprocessor(&per_cu, (const void*)fwd, NTHR, LDS_BYTES);
        if (per_cu < 1) per_cu = 1;
        grid_blocks = cus * per_cu;
        if (n_in != 24 || out_size != M * D || ws_size < 256 * MiB) fprintf(stderr, "kernel_launch: unexpected shapes n_in %d out %d ws %zu\n", n_in, out_size, ws_size);
    }
    Params p{};
    for (int i = 0; i < 24; ++i) p.in[i] = (const float*)d_in[i];
    p.out = (float*)d_out; p.ws = (unsigned char*)d_ws;
    void* args[] = {&p};
    hipError_t e = hipLaunchCooperativeKernel((void*)fwd, dim3(grid_blocks), dim3(NTHR), args, LDS_BYTES, stream);
    if (e != hipSuccess) fprintf(stderr, "cooperative launch failed: %s (grid %d)\n", hipGetErrorString(e), grid_blocks);
}
```

```cpp
#include <hip/hip_runtime.h>
#include <hip/hip_cooperative_groups.h>
#include <cstdio>
#include <cstdint>
namespace cg = cooperative_groups;
namespace pg8 {
#define PG8_LAS __attribute__((address_space(3)))
typedef unsigned short bf16_t;
typedef short bf16x8 __attribute__((ext_vector_type(8)));
typedef float f32x4 __attribute__((ext_vector_type(4)));
typedef unsigned u32x4 __attribute__((ext_vector_type(4)));
constexpr int BM = 256, BK = 64, HALF = 128, HTB = HALF * BK * 2  , STAGE_BYTES = 8 * HTB, NXCD = 8, WGM = 8;

__host__ __device__ __forceinline__ int lds_byte(int r, int c) { const int st = (r >> 4) * 2 + (c >> 5), rr = r & 15, cc = c & 31, ob = rr * 64 + cc * 2; return st * 1024 + (ob ^ (((ob >> 9) & 1) << 5)); }
__host__ __device__ __forceinline__ void stage_rc(int b, int& R, int& C) { const int st = b / 1024, sb = b % 1024, swz = sb ^ (((sb >> 9) & 1) << 5); R = (st >> 1) * 16 + swz / 64; C = (st & 1) * 32 + (swz % 64) / 2; }
__host__ __device__ __forceinline__ int perm32(int rho) { const int n = rho >> 4, i = rho & 15; return 8 * (i >> 2) + 4 * n + (i & 3); }

struct Unit { int pm, pn; };
struct Gemm { const bf16_t* A; const bf16_t* Bt; int M, N, K; };

struct StaticOrder {
    int nM, nN, nwg, G, c;
    __host__ __device__ void init(int M, int N, int G_, int c_) { nM = M / BM; nN = N / BM; nwg = nM * nN; G = G_; c = c_; }
    __host__ __device__ bool next(int i, Unit& u) const {
        const long L = (long)i * G + c; if (L >= nwg) return false;
        int wgid = (int)L; { const int q = nwg / NXCD, r = nwg % NXCD, xcd = wgid % NXCD, off = wgid / NXCD; wgid = (xcd < r ? xcd * (q + 1) : r * (q + 1) + (xcd - r) * q) + off; }
        const int nig = WGM * nN, gid = wgid / nig, fm = gid * WGM, gsz = (nM - fm) < WGM ? (nM - fm) : WGM;
        u.pm = fm + ((wgid % nig) % gsz); u.pn = (wgid % nig) / gsz; return true;
    }
    __device__ __forceinline__ void a_ready(const Unit&) const {}
    __device__ __forceinline__ void done(const Unit&) const {}
};

typedef float f32x2 __attribute__((ext_vector_type(2)));
typedef __bf16 bf16x2_t __attribute__((ext_vector_type(2)));
__device__ __forceinline__ unsigned cvt_pk_bf16(float lo, float hi) { f32x2 v = {lo, hi}; bf16x2_t b = __builtin_convertvector(v, bf16x2_t); return __builtin_bit_cast(unsigned, b); }
__device__ __forceinline__ float bflo(unsigned w) { return __uint_as_float(w << 16); }
__device__ __forceinline__ float bfhi(unsigned w) { return __uint_as_float(w & 0xffff0000u); }
__device__ __forceinline__ float sigmoidf_(float x) { return 1.0f / (1.0f + __expf(-x)); }

template <int MODE> struct Epi {
    static constexpr bool PERM = true, AFTER_DRAIN = false;
    bf16_t* o0; bf16_t* o1; bf16_t* o2; float* of; int ldc; const float* bias; const bf16_t* gate; int gcol0; const bf16_t* tmp;
    __device__ __forceinline__ void operator()(const f32x4 (&acc)[2][2][4][2], const Unit& u, int wr, int wc, int fr, int fq) const {
        const int row0 = u.pm * BM + wr * 64 + fr;
        int colt = u.pn * BM; bf16_t* base = o0; int ld = ldc; float sc = 1.f;
        if (MODE == 0) {
            if (u.pn < 2) { base = o0; ld = 512; sc = 0.125f; }
            else if (u.pn < 4) { base = o1; ld = 512; colt -= 512; }
            else { base = o2; ld = 1792; colt -= 1024; }
        }
        const int col0 = colt + wc * 32 + 8 * fq;
        const int gc0 = u.pn * BM + wc * 32 + 8 * fq;
#pragma unroll
        for (int ai = 0; ai < 2; ++ai)
#pragma unroll
            for (int m = 0; m < 4; ++m) {
                const size_t row = (size_t)(row0 + ai * HALF + m * 16);
#pragma unroll
                for (int bj = 0; bj < 2; ++bj) {
                    f32x4 v0 = acc[ai][bj][m][0], v1 = acc[ai][bj][m][1];
                    const int col = col0 + bj * HALF, gc = gc0 + bj * HALF;
                    if (MODE == 5) {
                        float* p = of + row * ld + col; *(f32x4*)p = v0; *(f32x4*)(p + 4) = v1;
                    } else {
                        if (MODE == 0) { v0 = v0 * sc; v1 = v1 * sc; }
                        if (MODE == 2) {
                            const f32x4 b0 = *(const f32x4*)(bias + gc), b1 = *(const f32x4*)(bias + gc + 4);
#pragma unroll
                            for (int e = 0; e < 4; ++e) { v0[e] = sigmoidf_(v0[e] + b0[e]); v1[e] = sigmoidf_(v1[e] + b1[e]); }
                        }
                        if (MODE == 3 || MODE == 4) {
                            const u32x4 g = *(const u32x4*)(gate + row * 2048 + gcol0 + gc);
                            v0[0] *= bflo(g.x); v0[1] *= bfhi(g.x); v0[2] *= bflo(g.y); v0[3] *= bfhi(g.y);
                            v1[0] *= bflo(g.z); v1[1] *= bfhi(g.z); v1[2] *= bflo(g.w); v1[3] *= bfhi(g.w);
                        }
                        if (MODE == 4) {
                            const u32x4 t = *(const u32x4*)(tmp + row * ld + col);
                            v0[0] += bflo(t.x); v0[1] += bfhi(t.x); v0[2] += bflo(t.y); v0[3] += bfhi(t.y);
                            v1[0] += bflo(t.z); v1[1] += bfhi(t.z); v1[2] += bflo(t.w); v1[3] += bfhi(t.w);
                        }
                        if (MODE == 6) {
#pragma unroll
                            for (int e = 0; e < 4; ++e) { float a = fmaxf(v0[e], 0.f), b = fmaxf(v1[e], 0.f); v0[e] = a * a; v1[e] = b * b; }
                        }
                        u32x4 w; w.x = cvt_pk_bf16(v0[0], v0[1]); w.y = cvt_pk_bf16(v0[2], v0[3]); w.z = cvt_pk_bf16(v1[0], v1[1]); w.w = cvt_pk_bf16(v1[2], v1[3]);
                        *(u32x4*)(base + row * ld + col) = w;
                    }
                }
            }
    }
};

template <class Epi, class Sched, bool ALIGN_EPI = false, bool SP2 = false>
__device__ __forceinline__ void gemm_phase(PG8_LAS unsigned char* lds, const Gemm g, const Sched& S, const Epi& E) {
    int tid_ = threadIdx.x; asm volatile("" : "+v"(tid_) :: "memory");
    const int tid = tid_, wid = __builtin_amdgcn_readfirstlane(tid >> 6), lane = tid & 63, wr = wid >> 2, wc = wid & 3, fr = lane & 15, fq = lane >> 4;
    const int K = g.K, nt = K / BK;
    unsigned voffA[2], voffB[2];
#pragma unroll
    for (int i = 0; i < 2; ++i) { int R, C; stage_rc(tid * 16 + i * 8192, R, C); const int Rb = Epi::PERM ? ((R & ~31) + perm32(R & 31)) : R;
        voffA[i] = (unsigned)(R * K + C) * 2u; voffB[i] = (unsigned)(Rb * K + C) * 2u; }
    const size_t kstep = (size_t)(BK * 2);
    const size_t hstep = (size_t)HALF * K * 2;
    const size_t tstep = 2 * hstep;
    const unsigned ldsw = (unsigned)wid * 1024u;
    const int aoff = lds_byte(wr * 64 + fr, fq * 8), boff = lds_byte(wc * 32 + fr, fq * 8);
#define PG8_SA(b, h) (((b) * 2 + (h)) * HTB)
#define PG8_SB(b, h) ((4 + (b) * 2 + (h)) * HTB)
#define PG8_STAGE(bufoff, gbase, voff) do { _Pragma("unroll") for (int _i = 0; _i < 2; ++_i) \
        __builtin_amdgcn_global_load_lds((const unsigned*)((const char*)(gbase) + (voff)[_i]), (PG8_LAS unsigned*)(lds + (bufoff) + ldsw + _i * 8192), 16, 0, 0); } while (0)
#define PG8_LDA(dst, b, h) do { _Pragma("unroll") for (int m = 0; m < 4; ++m) _Pragma("unroll") for (int k = 0; k < 2; ++k) dst[m][k] = *(const PG8_LAS bf16x8*)(lds + PG8_SA(b, h) + aoff + m * 2048 + k * 1024); } while (0)
#define PG8_LDB(dst, b, h) do { _Pragma("unroll") for (int n = 0; n < 2; ++n) _Pragma("unroll") for (int k = 0; k < 2; ++k) dst[n][k] = *(const PG8_LAS bf16x8*)(lds + PG8_SB(b, h) + boff + n * 2048 + k * 1024); } while (0)
#define PG8_MMA(ai, bj, At, Bt) do { __builtin_amdgcn_s_setprio(1); _Pragma("unroll") for (int m = 0; m < 4; ++m) _Pragma("unroll") for (int n = 0; n < 2; ++n) _Pragma("unroll") for (int k = 0; k < 2; ++k) \
        acc[ai][bj][m][n] = __builtin_amdgcn_mfma_f32_16x16x32_bf16(Bt[n][k], At[m][k], acc[ai][bj][m][n], 0, 0, 0); __builtin_amdgcn_s_setprio(0); } while (0)
#define PG8_WAIT_V(n) asm volatile("s_waitcnt vmcnt(" #n ")" ::: "memory")
#define PG8_WAIT_L(n) asm volatile("s_waitcnt lgkmcnt(" #n ")" ::: "memory")
#define PG8_BAR __builtin_amdgcn_s_barrier()
#define PG8_SCHED __builtin_amdgcn_sched_barrier(0)
    Unit cur, nxt; int ui = 0;
    if (!S.next(0, cur)) return;
    f32x4 acc[2][2][4][2];
#pragma unroll
    for (int a = 0; a < 2; ++a)
#pragma unroll
        for (int b = 0; b < 2; ++b)
#pragma unroll
            for (int m = 0; m < 4; ++m)
#pragma unroll
                for (int n = 0; n < 2; ++n) acc[a][b][m][n] = (f32x4){0.f, 0.f, 0.f, 0.f};
    bf16x8 At[4][2], B0[2][2], B1[2][2];
    const char* cA = (const char*)g.A + (size_t)cur.pm * tstep; const char* cB = (const char*)g.Bt + (size_t)cur.pn * tstep;
    S.a_ready(cur);
    if constexpr (SP2) {
        PG8_STAGE(PG8_SB(0, 0), cB, voffB); PG8_STAGE(PG8_SB(0, 1), cB + hstep, voffB); PG8_STAGE(PG8_SA(0, 0), cA, voffA); PG8_STAGE(PG8_SA(0, 1), cA + hstep, voffA);
        if (wr == 1) PG8_BAR;
        PG8_WAIT_V(2); PG8_BAR;
        PG8_STAGE(PG8_SB(1, 0), cB + kstep, voffB); PG8_STAGE(PG8_SA(1, 0), cA + kstep, voffA); PG8_STAGE(PG8_SB(1, 1), cB + hstep + kstep, voffB);
        PG8_WAIT_V(6); PG8_BAR;
    } else {
        PG8_STAGE(PG8_SB(0, 0), cB, voffB); PG8_STAGE(PG8_SA(0, 0), cA, voffA); PG8_STAGE(PG8_SB(0, 1), cB + hstep, voffB); PG8_STAGE(PG8_SA(0, 1), cA + hstep, voffA);
        if (wr == 1) PG8_BAR;
        PG8_WAIT_V(4); PG8_BAR;
        PG8_STAGE(PG8_SB(1, 0), cB + kstep, voffB); PG8_STAGE(PG8_SA(1, 0), cA + kstep, voffA); PG8_STAGE(PG8_SB(1, 1), cB + hstep + kstep, voffB);
        PG8_WAIT_V(6); PG8_BAR;
    }
    for (;;) {
        const bool has_next = S.next(ui + 1, nxt);
        const char* nA = has_next ? (const char*)g.A + (size_t)nxt.pm * tstep : cA; const char* nB = has_next ? (const char*)g.Bt + (size_t)nxt.pn * tstep : cB;
        for (int t = 0; t < nt; t += 2) {
            const bool last = (t == nt - 2);
            const char* a1 = cA + (size_t)(t + 1) * kstep;
            const char* a2 = last ? nA : cA + (size_t)(t + 2) * kstep; const char* b2 = last ? nB : cB + (size_t)(t + 2) * kstep;
            const char* a3 = a2 + kstep; const char* b3 = b2 + kstep;
            if (last && has_next) S.a_ready(nxt);
            if constexpr (SP2) {
            PG8_LDB(B0, 0, 0); PG8_LDB(B1, 0, 1); PG8_SCHED; PG8_LDA(At, 0, 0); PG8_STAGE(PG8_SA(1, 1), a1 + hstep, voffA);
            PG8_WAIT_V(8); PG8_WAIT_L(0); PG8_BAR; PG8_MMA(0, 0, At, B0); PG8_MMA(0, 1, At, B1); PG8_BAR; PG8_SCHED;
            PG8_LDA(At, 0, 1); PG8_STAGE(PG8_SB(0, 0), b2, voffB); PG8_STAGE(PG8_SB(0, 1), b2 + hstep, voffB); PG8_STAGE(PG8_SA(0, 0), a2, voffA);
            PG8_WAIT_V(8); PG8_WAIT_L(0); PG8_BAR; PG8_MMA(1, 0, At, B0); PG8_MMA(1, 1, At, B1); PG8_BAR; PG8_SCHED;
            PG8_LDB(B0, 1, 0); PG8_LDB(B1, 1, 1); PG8_SCHED; PG8_LDA(At, 1, 0); PG8_STAGE(PG8_SA(0, 1), a2 + hstep, voffA);
            PG8_WAIT_V(8); PG8_WAIT_L(0); PG8_BAR; PG8_MMA(0, 0, At, B0); PG8_MMA(0, 1, At, B1); PG8_BAR; PG8_SCHED;
            PG8_LDA(At, 1, 1); PG8_STAGE(PG8_SB(1, 0), b3, voffB); PG8_STAGE(PG8_SB(1, 1), b3 + hstep, voffB); PG8_STAGE(PG8_SA(1, 0), a3, voffA);
            PG8_WAIT_V(8); PG8_WAIT_L(0); PG8_BAR; PG8_MMA(1, 0, At, B0); PG8_MMA(1, 1, At, B1); PG8_BAR; PG8_SCHED;
            } else {
            PG8_LDB(B0, 0, 0); PG8_SCHED; PG8_LDA(At, 0, 0); PG8_STAGE(PG8_SA(1, 1), a1 + hstep, voffA);
            PG8_WAIT_L(8); PG8_BAR; PG8_WAIT_L(0); PG8_MMA(0, 0, At, B0); PG8_BAR; PG8_SCHED;
            PG8_LDB(B1, 0, 1); PG8_STAGE(PG8_SB(0, 0), b2, voffB);
            PG8_BAR; PG8_WAIT_L(0); PG8_MMA(0, 1, At, B1); PG8_BAR;
            PG8_LDA(At, 0, 1); PG8_STAGE(PG8_SA(0, 0), a2, voffA);
            PG8_BAR; PG8_WAIT_L(0); PG8_MMA(1, 0, At, B0); PG8_BAR; PG8_SCHED;
            PG8_STAGE(PG8_SB(0, 1), b2 + hstep, voffB);
            PG8_WAIT_V(6); PG8_BAR; PG8_MMA(1, 1, At, B1); PG8_BAR;
            PG8_LDB(B0, 1, 0); PG8_SCHED; PG8_LDA(At, 1, 0); PG8_STAGE(PG8_SA(0, 1), a2 + hstep, voffA);
            PG8_WAIT_L(8); PG8_BAR; PG8_WAIT_L(0); PG8_MMA(0, 0, At, B0); PG8_BAR; PG8_SCHED;
            PG8_LDB(B1, 1, 1); PG8_STAGE(PG8_SB(1, 0), b3, voffB);
            PG8_BAR; PG8_WAIT_L(0); PG8_MMA(0, 1, At, B1); PG8_BAR;
            PG8_LDA(At, 1, 1); PG8_STAGE(PG8_SA(1, 0), a3, voffA);
            PG8_BAR; PG8_WAIT_L(0); PG8_MMA(1, 0, At, B0); PG8_BAR; PG8_SCHED;
            PG8_STAGE(PG8_SB(1, 1), b3 + hstep, voffB);
            PG8_WAIT_V(6); PG8_BAR; PG8_MMA(1, 1, At, B1); PG8_BAR;
            }
        }
        if constexpr (ALIGN_EPI) { if (wr == 0) PG8_BAR; }
        if constexpr (!Epi::AFTER_DRAIN) { E(acc, cur, wr, wc, fr, fq); S.done(cur); }
        if (!has_next) break;
#pragma unroll
        for (int a = 0; a < 2; ++a)
#pragma unroll
            for (int b = 0; b < 2; ++b)
#pragma unroll
                for (int m = 0; m < 4; ++m)
#pragma unroll
                    for (int n = 0; n < 2; ++n) acc[a][b][m][n] = (f32x4){0.f, 0.f, 0.f, 0.f};
        cur = nxt; cA = nA; cB = nB; ++ui;
        if constexpr (ALIGN_EPI) { if (wr == 1) PG8_BAR; }
    }
    PG8_WAIT_V(0);
    if constexpr (!ALIGN_EPI) { if (wr == 0) PG8_BAR; }
    PG8_BAR;
    if constexpr (Epi::AFTER_DRAIN) { E.fused(acc, cur, wr, wc, fr, fq, lds, wid, lane); S.done(cur); }
#undef PG8_SA
#undef PG8_SB
#undef PG8_STAGE
#undef PG8_LDA
#undef PG8_LDB
#undef PG8_MMA
#undef PG8_WAIT_V
#undef PG8_WAIT_L
#undef PG8_BAR
#undef PG8_SCHED
}
}

#ifndef PG8_SP2
#define PG8_SP2 true
#endif
#ifndef PG8_ALIGN
#define PG8_ALIGN true
#endif

#define DI __device__ __forceinline__
#define LAS __attribute__((address_space(3)))
typedef unsigned short bf16;
typedef float f32x4 __attribute__((ext_vector_type(4)));
typedef float f32x16 __attribute__((ext_vector_type(16)));
typedef short bf16x8 __attribute__((ext_vector_type(8)));
typedef unsigned u32x4 __attribute__((ext_vector_type(4)));
typedef unsigned u32x2 __attribute__((ext_vector_type(2)));
using pg8::cvt_pk_bf16; using pg8::bflo; using pg8::bfhi; using pg8::sigmoidf_;

constexpr int SEQ = 8192, NB = 2, M = NB * SEQ, D = 1024, FF = 4096;
constexpr int NWAVES = 8, NTHR = 512;
constexpr int LDS_BYTES = 136 * 1024;
constexpr int MISC_OFF = 128 * 1024;
constexpr float RMS_EPS = 1e-6f, GN_EPS = 64e-5f;
#ifndef PROBE
#define PROBE 0
#endif
#ifndef SEQ_SCAN
#define SEQ_SCAN 0
#endif

constexpr size_t KiB = 1024, MiB = 1u << 20;
constexpr size_t W_A = 1 * MiB;
constexpr size_t W_V = W_A + 2816 * 1024 * 2;
constexpr size_t W_G = W_V + 512 * 1024 * 2;
constexpr size_t W_PA = W_G + 2048 * 1024 * 2;
constexpr size_t W_PB = W_PA + 1 * MiB;
constexpr size_t W_O = W_PB + 1 * MiB;
constexpr size_t W_UP = W_O + 2 * MiB;
constexpr size_t W_DN = W_UP + 8 * MiB;
constexpr size_t W_L2 = W_DN + 8 * MiB;
constexpr size_t W_LA = W_L2 + 64 * KiB;
constexpr size_t W_LG = W_LA + 64 * KiB;
constexpr size_t WS_XN = 32 * MiB;
constexpr size_t WS_Q = 64 * MiB, WS_K = 80 * MiB, WS_VT = 96 * MiB;
constexpr size_t WS_AA = 112 * MiB, WS_BB = 128 * MiB, WS_K2 = 144 * MiB, WS_WR = 160 * MiB;
constexpr size_t WS_WW = 176 * MiB;
constexpr size_t WS_VV = 208 * MiB, WS_GG = 224 * MiB;
constexpr size_t WS_SC = 240 * MiB;
constexpr size_t WS_SCH = WS_K;
constexpr size_t WS_YB = WS_VT;
constexpr size_t WS_G = 112 * MiB;
constexpr size_t WS_TMP = 176 * MiB;
constexpr size_t WS_MG = 208 * MiB;
constexpr size_t WS_Z = 32 * MiB;
constexpr size_t WS_HF = 96 * MiB;
constexpr size_t WS_H = 128 * MiB;
static_assert(W_LG + 128 * KiB <= WS_XN, "weights fit below XN");
constexpr size_t O_MT = 0, O_SL = 16 * MiB, O_YI = 32 * MiB, O_YL = 48 * MiB;

struct Params { const float* in[24]; float* out; unsigned char* ws; };
enum { I_X = 0, I_PREG, I_WIN, I_GBIAS, I_RELB, I_MU, I_W0, I_W2, I_A0, I_A2, I_G2, I_KK, I_KA, I_RK, I_LNW, I_LNB, I_PA, I_PB, I_WO, I_POSTG, I_PREF, I_WUP, I_WDN, I_POSTF };

DI float wave_sum(float v) {
#pragma unroll
    for (int o = 1; o < 64; o <<= 1) v += __shfl_xor(v, o);
    return v;
}
DI float quad_sum(float x) {
    x += __builtin_bit_cast(float, __builtin_amdgcn_update_dpp(0, __builtin_bit_cast(int, x), 0xB1, 0xF, 0xF, true));
    x += __builtin_bit_cast(float, __builtin_amdgcn_update_dpp(0, __builtin_bit_cast(int, x), 0x4E, 0xF, 0xF, true));
    return x;
}
DI float row16_sum(float x) {
    x += __shfl_xor(x, 1); x += __shfl_xor(x, 2); x += __shfl_xor(x, 4); x += __shfl_xor(x, 8);
    return x;
}

typedef __attribute__((address_space(1))) unsigned gu32;
#define XB_TMO      128
#define XB_XCNT(j)  (256  + 64 * (j))
#define XB_XSUB(j)  (1280 + 64 * (j))
#define XB_XGEN(j)  (2304 + 64 * (j))
#define XB_TOP      3328
#define XB_TOPGEN   3392
#define XCD_BAR_WORDS 3456
#define XB_SPIN_CAP (1u << 18)

__device__ __forceinline__ unsigned xb_ld(unsigned* p)              { return __hip_atomic_load(p, __ATOMIC_RELAXED, __HIP_MEMORY_SCOPE_AGENT); }
__device__ __forceinline__ unsigned xb_add(unsigned* p, unsigned v) { return __hip_atomic_fetch_add(p, v, __ATOMIC_RELAXED, __HIP_MEMORY_SCOPE_AGENT); }
__device__ __forceinline__ unsigned xb_xcc_id() { return (unsigned)__builtin_amdgcn_s_getreg((3 << 11) | 20) & 0xFu; }
#define XB_SPIN(cond, bar) do { unsigned _sp = 0; while (cond) { __builtin_amdgcn_s_sleep(1); \
    if ((++_sp & 255u) == 0u) { if (xb_ld(&(bar)[XB_TMO])) break; if (_sp > XB_SPIN_CAP) { atomicAdd(&(bar)[XB_TMO], 1u); break; } } } } while (0)

struct XcdBarrier {
    unsigned* bar; unsigned x;
    volatile LAS unsigned* st;
};

__device__ __forceinline__ XcdBarrier xcd_barrier_post(unsigned* bar, volatile LAS unsigned* st) {
    XcdBarrier b; b.bar = bar; b.x = xb_xcc_id(); b.st = st;
    if (threadIdx.x == 0) (void)xb_add(&bar[XB_XCNT(b.x)], 1u);
    return b;
}
__device__ __forceinline__ void xcd_barrier_complete(unsigned* bar, unsigned x, unsigned& nloc, unsigned& nx) {
    const unsigned G = gridDim.x * gridDim.y * gridDim.z;
    unsigned sum, cnt, mine, sp = 0u;
    for (;;) {
        sum = 0u; cnt = 0u; mine = 0u;
#pragma unroll
        for (unsigned j = 0; j < 16; ++j) { const unsigned c = xb_ld(&bar[XB_XCNT(j)]); sum += c; cnt += (c > 0u) ? 1u : 0u; mine = (j == x) ? c : mine; }
        if (sum == G) break;
        __builtin_amdgcn_s_sleep(1);
        if ((++sp & 255u) == 0u) { if (xb_ld(&bar[XB_TMO])) break; if (sp > XB_SPIN_CAP) { atomicAdd(&bar[XB_TMO], 1u); break; } }
    }
    nloc = mine > 0u ? mine : 1u; nx = cnt > 0u ? cnt : 1u;
}

__device__ __forceinline__ void xcd_barrier(const XcdBarrier& b) {
    asm volatile("s_waitcnt vmcnt(0)" ::: "memory");
    __syncthreads();
    if (threadIdx.x == 0) {
        unsigned* bar = b.bar;
        __builtin_amdgcn_s_waitcnt(0);
        unsigned nloc = b.st[0], nx = b.st[1];
        if (nloc == 0u) { xcd_barrier_complete(bar, b.x, nloc, nx); b.st[0] = nloc; b.st[1] = nx; }
        const unsigned old = xb_add(&bar[XB_XSUB(b.x)], 1u);
        const unsigned gen = old / nloc;
        if (old + 1u == (gen + 1u) * nloc) {
            __builtin_amdgcn_fence(__ATOMIC_RELEASE, "agent");
            asm volatile("s_waitcnt vmcnt(0)" ::: "memory");
            const unsigned og = xb_add(&bar[XB_TOP], 1u);
            const unsigned tg = og / nx;
            if (og + 1u == (tg + 1u) * nx) xb_add(&bar[XB_TOPGEN], 1u);
            else XB_SPIN(xb_ld(&bar[XB_TOPGEN]) == tg, bar);
            __builtin_amdgcn_fence(__ATOMIC_ACQUIRE, "agent");
            xb_add(&bar[XB_XGEN(b.x)], 1u);
            asm volatile("s_waitcnt vmcnt(0)" ::: "memory");
        } else {
            XB_SPIN(xb_ld(&bar[XB_XGEN(b.x)]) == gen, bar);
            __builtin_amdgcn_fence(__ATOMIC_ACQUIRE, "agent");
            asm volatile("s_waitcnt vmcnt(0)" ::: "memory");
        }
    }
    __syncthreads();
}

DI void p0_transpose_item(const float* W, int K, int ldw, int src_c0, int ncols, bf16* WT, int dst_r0, LAS float* scr, int item, int lane) {
    const int nblk = ncols / 32, kb = item / nblk, nb = item % nblk, k0 = 64 * kb, n0 = 32 * nb;
#pragma unroll 8
    for (int i = 0; i < 32; ++i) { const int kk = 2 * i + (lane >> 5); scr[kk * 33 + (lane & 31)] = W[(size_t)(k0 + kk) * ldw + src_c0 + n0 + (lane & 31)]; }
    asm volatile("s_waitcnt lgkmcnt(0)" ::: "memory");
    const int c = lane & 7;
#pragma unroll
    for (int j = 0; j < 4; ++j) { const int n = (lane >> 3) + 8 * j; const LAS float* s = scr + (8 * c) * 33 + n;
        u32x4 o; o.x = cvt_pk_bf16(s[0 * 33], s[1 * 33]); o.y = cvt_pk_bf16(s[2 * 33], s[3 * 33]); o.z = cvt_pk_bf16(s[4 * 33], s[5 * 33]); o.w = cvt_pk_bf16(s[6 * 33], s[7 * 33]);
        *(u32x4*)(WT + (size_t)(dst_r0 + n0 + n) * K + k0 + 8 * c) = o; }
    asm volatile("s_waitcnt lgkmcnt(0)" ::: "memory");
}
DI void rms_row_to_bf16(const float* xrow, const float* g, bf16* orow, int lane) {
    const f32x4* xr = (const f32x4*)xrow + lane; const f32x4* gr = (const f32x4*)g + lane;
    f32x4 v[4]; float s = 0.f;
#pragma unroll
    for (int j = 0; j < 4; ++j) { v[j] = xr[64 * j]; s += (v[j].x * v[j].x + v[j].y * v[j].y) + (v[j].z * v[j].z + v[j].w * v[j].w); }
    const float rs = rsqrtf(wave_sum(s) * (1.f / D) + RMS_EPS);
    u32x2* o8 = (u32x2*)orow + lane;
#pragma unroll
    for (int j = 0; j < 4; ++j) { const f32x4 gg = gr[64 * j]; u32x2 w; w.x = cvt_pk_bf16(v[j].x * rs * gg.x, v[j].y * rs * gg.y); w.y = cvt_pk_bf16(v[j].z * rs * gg.z, v[j].w * rs * gg.w); o8[64 * j] = w; }
}
DI void phase0(const Params& p, LAS unsigned char* lds, int wave, int lane) {
    LAS float* scr = (LAS float*)(lds + wave * 16384);
    unsigned char* ws = p.ws;
    const int gw = blockIdx.x * NWAVES + wave, NGW = gridDim.x * NWAVES;
    constexpr int IT_QK = 16 * 32, IT_V = 16 * 16, IT_R = 16 * 56, IT_G = 16 * 64, IT_PA = 8 * 32, IT_PB = 8 * 32, IT_O = 16 * 32, IT_UP = 16 * 128, IT_DN = 64 * 32, IT_L2 = 16, IT_LA = 16, IT_LG = 2 * 16;
    constexpr int NITEMS = IT_QK + IT_V + IT_R + IT_G + IT_PA + IT_PB + IT_O + IT_UP + IT_DN + IT_L2 + IT_LA + IT_LG;
    for (int it = gw; it < NITEMS; it += NGW) {
        int r = it;
        if (r < IT_QK) { p0_transpose_item(p.in[I_WIN], 1024, 5376, 0, 1024, (bf16*)(ws + W_A), 0, scr, r, lane); continue; } r -= IT_QK;
        if (r < IT_V) { p0_transpose_item(p.in[I_WIN], 1024, 5376, 1024, 512, (bf16*)(ws + W_V), 0, scr, r, lane); continue; } r -= IT_V;
        if (r < IT_R) { p0_transpose_item(p.in[I_WIN], 1024, 5376, 1536, 1792, (bf16*)(ws + W_A), 1024, scr, r, lane); continue; } r -= IT_R;
        if (r < IT_G) { p0_transpose_item(p.in[I_WIN], 1024, 5376, 3328, 2048, (bf16*)(ws + W_G), 0, scr, r, lane); continue; } r -= IT_G;
        if (r < IT_PA) { p0_transpose_item(p.in[I_PA], 512, 1024, 0, 1024, (bf16*)(ws + W_PA), 0, scr, r, lane); continue; } r -= IT_PA;
        if (r < IT_PB) { p0_transpose_item(p.in[I_PB], 512, 1024, 0, 1024, (bf16*)(ws + W_PB), 0, scr, r, lane); continue; } r -= IT_PB;
        if (r < IT_O) { p0_transpose_item(p.in[I_WO], 1024, 1024, 0, 1024, (bf16*)(ws + W_O), 0, scr, r, lane); continue; } r -= IT_O;
        if (r < IT_UP) { p0_transpose_item(p.in[I_WUP], 1024, 4096, 0, 4096, (bf16*)(ws + W_UP), 0, scr, r, lane); continue; } r -= IT_UP;
        if (r < IT_DN) { p0_transpose_item(p.in[I_WDN], 4096, 1024, 0, 1024, (bf16*)(ws + W_DN), 0, scr, r, lane); continue; } r -= IT_DN;
        if (r < IT_L2) { p0_transpose_item(p.in[I_W2], 64, 512, 0, 512, (bf16*)(ws + W_L2), 0, scr, r, lane); continue; } r -= IT_L2;
        if (r < IT_LA) { p0_transpose_item(p.in[I_A2], 64, 512, 0, 512, (bf16*)(ws + W_LA), 0, scr, r, lane); continue; } r -= IT_LA;
        p0_transpose_item(p.in[I_G2], 128, 512, 0, 512, (bf16*)(ws + W_LG), 0, scr, r, lane);
    }
    bf16* XN = (bf16*)(ws + WS_XN);
    for (int m = gw; m < M; m += NGW) rms_row_to_bf16(p.in[I_X] + (size_t)m * D, p.in[I_PREG], XN + (size_t)m * D, lane);
}

DI float tanhf_(float x) { const float e = __expf(-2.f * fabsf(x)); const float t = (1.f - e) / (1.f + e); return x < 0.f ? -t : t; }
DI void phase2(const Params& p, LAS unsigned char* lds, int wave, int lane) {
    unsigned char* ws = p.ws;
    const bf16* Rraw = (const bf16*)p.out;
    const float* mu = p.in[I_MU];
    constexpr int APITCH = 264;
    LAS bf16* At = (LAS bf16*)lds;
    const bf16* w2t = (const bf16*)(ws + W_L2); const bf16* a2t = (const bf16*)(ws + W_LA); const bf16* g2t = (const bf16*)(ws + W_LG);
    bf16* AA = (bf16*)(ws + WS_AA); bf16* BB = (bf16*)(ws + WS_BB); bf16* K2 = (bf16*)(ws + WS_K2); bf16* WR = (bf16*)(ws + WS_WR);
    float* WW = (float*)(ws + WS_WW); bf16* VV = (bf16*)(ws + WS_VV); bf16* GG = (bf16*)(ws + WS_GG); float* SC = (float*)(ws + WS_SC);
    const int tid = wave * 64 + lane, h = wave, c = lane & 15, q = lane >> 4;
    for (int tt = blockIdx.x; tt < M / 16; tt += gridDim.x) {
        const int m0 = tt * 16;
        __syncthreads();
#pragma unroll
        for (int i = 0; i < 8; ++i) {
            const int e = tid + NTHR * i, tk = e >> 8, ci = e & 255, m = m0 + tk, col = 1536 + ci;
            const float cur = bflo((unsigned)Rraw[(size_t)m * 1792 + col]);
            const float prv = (m & (SEQ - 1)) ? bflo((unsigned)Rraw[(size_t)(m - 1) * 1792 + col]) : 0.f;
            float x = cur + (prv - cur) * mu[col];
            if (ci < 64) x = tanhf_(x); else if (ci >= 128) x = sigmoidf_(x);
            At[tk * APITCH + ci] = (bf16)(cvt_pk_bf16(x, 0.f) & 0xffffu);
        }
        __syncthreads();
        f32x4 accw[4], acca[4], accg[4];
#pragma unroll
        for (int nt = 0; nt < 4; ++nt) { accw[nt] = (f32x4){0.f, 0.f, 0.f, 0.f}; acca[nt] = accw[nt]; accg[nt] = accw[nt]; }
        const LAS bf16* arow = At + (lane & 15) * APITCH + 8 * q;
#pragma unroll
        for (int ks = 0; ks < 2; ++ks) {
            const bf16x8 aw = *(const LAS bf16x8*)(arow + 32 * ks), aa_ = *(const LAS bf16x8*)(arow + 64 + 32 * ks);
#pragma unroll
            for (int nt = 0; nt < 4; ++nt) {
                const size_t wrow = (size_t)(h * 64 + 16 * nt + c);
                const bf16x8 bw = *(const bf16x8*)(w2t + wrow * 64 + 32 * ks + 8 * q), ba = *(const bf16x8*)(a2t + wrow * 64 + 32 * ks + 8 * q);
                accw[nt] = __builtin_amdgcn_mfma_f32_16x16x32_bf16(aw, bw, accw[nt], 0, 0, 0);
                acca[nt] = __builtin_amdgcn_mfma_f32_16x16x32_bf16(aa_, ba, acca[nt], 0, 0, 0);
            }
        }
#pragma unroll
        for (int ks = 0; ks < 4; ++ks) {
            const bf16x8 ag = *(const LAS bf16x8*)(arow + 128 + 32 * ks);
#pragma unroll
            for (int nt = 0; nt < 4; ++nt) {
                const bf16x8 bg = *(const bf16x8*)(g2t + (size_t)(h * 64 + 16 * nt + c) * 128 + 32 * ks + 8 * q);
                accg[nt] = __builtin_amdgcn_mfma_f32_16x16x32_bf16(ag, bg, accg[nt], 0, 0, 0);
            }
        }
#pragma unroll
        for (int rp = 0; rp < 4; ++rp) {
            const int m = m0 + 4 * q + rp; const bool has_prev = (m & (SEQ - 1)) != 0;
            const bf16* rc = Rraw + (size_t)m * 1792; const bf16* rpv = rc - 1792;
            float kkr[4], av[4], wv[4], k2v[4], rv[4], vv[4];
            float ss = 0.f, sbr = 0.f, skr = 0.f, sbo = 0.f;
#pragma unroll
            for (int nt = 0; nt < 4; ++nt) {
                const int col = h * 64 + 16 * nt + c;
                float r_ = bflo((unsigned)rc[col]), k_ = bflo((unsigned)rc[512 + col]), v_ = bflo((unsigned)rc[1024 + col]);
                const float rp_ = has_prev ? bflo((unsigned)rpv[col]) : 0.f, kp_ = has_prev ? bflo((unsigned)rpv[512 + col]) : 0.f, vp_ = has_prev ? bflo((unsigned)rpv[1024 + col]) : 0.f;
                r_ += (rp_ - r_) * mu[col]; k_ += (kp_ - k_) * mu[512 + col]; v_ += (vp_ - v_) * mu[1024 + col];
                const float a = sigmoidf_(acca[nt][rp] + p.in[I_A0][col]);
                const float x = accw[nt][rp] + p.in[I_W0][col];
                const float sp = fmaxf(-x, 0.f) + log1pf(__expf(-fabsf(x)));
                const float w = __expf(-__expf(-sp - 0.5f));
                const float kr_ = k_ * p.in[I_KK][col];
                const float k2 = k_ * (1.f + (a - 1.f) * p.in[I_KA][col]);
                kkr[nt] = kr_; av[nt] = a; wv[nt] = w; k2v[nt] = k2; rv[nt] = r_; vv[nt] = v_;
                ss += kr_ * kr_; sbr += kr_ * a * r_; skr += k2 * r_; sbo += r_ * k2 * p.in[I_RK][col];
            }
            ss = row16_sum(ss); sbr = row16_sum(sbr); skr = row16_sum(skr); sbo = row16_sum(sbo);
            const float inv = 1.f / fmaxf(sqrtf(ss), 1e-12f);
#pragma unroll
            for (int nt = 0; nt < 4; ++nt) {
                const size_t o = (size_t)m * 512 + h * 64 + 16 * nt + c;
                const float kk = kkr[nt] * inv;
                AA[o] = (bf16)(cvt_pk_bf16(-kk, 0.f) & 0xffffu);
                BB[o] = (bf16)(cvt_pk_bf16(kk * av[nt], 0.f) & 0xffffu);
                K2[o] = (bf16)(cvt_pk_bf16(k2v[nt], 0.f) & 0xffffu);
                WR[o] = (bf16)(cvt_pk_bf16(wv[nt] * rv[nt], 0.f) & 0xffffu);
                WW[o] = wv[nt];
                VV[o] = (bf16)(cvt_pk_bf16(vv[nt], 0.f) & 0xffffu);
                GG[o] = (bf16)(cvt_pk_bf16(accg[nt][rp], 0.f) & 0xffffu);
            }
            if (c == 0) *(f32x4*)(SC + ((size_t)m * 8 + h) * 4) = (f32x4){sbr * inv, skr, sbo, 0.f};
        }
    }
    __syncthreads();
}

#define MFMA32(a, b, c) __builtin_amdgcn_mfma_f32_32x32x16_bf16((a), (b), (c), 0, 0, 0)
DI int crow(int r, int hh) { return (r & 3) + 8 * (r >> 2) + 4 * hh; }
DI void attn_task(int task, const bf16* Q, const bf16* Kb, const bf16* Vt, bf16* yA, const LAS float* biasL, int lane) {
    const int half = task & 1, h = (task >> 1) & 7, n = (task >> 4) & 127, b = task >> 11;
    const int c = lane & 31, hh = lane >> 5;
    const int qi = 32 * half + c;
    const size_t mq = (size_t)b * SEQ + 64 * n + qi;
    bf16x8 qf[4];
#pragma unroll
    for (int ks = 0; ks < 4; ++ks) qf[ks] = *(const bf16x8*)(Q + mq * 512 + h * 64 + 16 * ks + 8 * hh);
    f32x16 o0, o1;
#pragma unroll
    for (int r = 0; r < 16; ++r) { o0[r] = 0.f; o1[r] = 0.f; }
    float mrun = -1e30f, l = 0.f;
    const LAS float* bl = biasL + h * 320;
    const int kt_min = n >= 8 ? 0 : 2 * (8 - n);
    for (int kt = kt_min; kt < 18; ++kt) {
        const size_t mk0 = (size_t)b * SEQ + 64 * (n - 8) + 32 * kt;
        f32x16 s;
#pragma unroll
        for (int r = 0; r < 16; ++r) s[r] = 0.f;
#pragma unroll
        for (int ks = 0; ks < 4; ++ks) { const bf16x8 kf = *(const bf16x8*)(Kb + (mk0 + c) * 512 + h * 64 + 16 * ks + 8 * hh); s = MFMA32(kf, qf[ks], s); }
        float mx = -1e30f;
#pragma unroll
        for (int r = 0; r < 16; ++r) {
            int dist = qi + 512 - (32 * kt + crow(r, hh));
            dist = dist < -63 ? -63 : (dist > 256 ? 256 : dist);
            s[r] += bl[dist + 63];
            mx = fmaxf(mx, s[r]);
        }
        mx = fmaxf(mx, __shfl_xor(mx, 32));
        const float mnew = fmaxf(mrun, mx), sc = __expf(mrun - mnew);
        float ps = 0.f;
#pragma unroll
        for (int r = 0; r < 16; ++r) { s[r] = __expf(s[r] - mnew); ps += s[r]; }
        ps += __shfl_xor(ps, 32);
        l = l * sc + ps; mrun = mnew;
#pragma unroll
        for (int r = 0; r < 16; ++r) { o0[r] *= sc; o1[r] *= sc; }
        bf16x8 pb[2];
#pragma unroll
        for (int s2 = 0; s2 < 2; ++s2) {
            u32x4 w; w.x = cvt_pk_bf16(s[8 * s2 + 0], s[8 * s2 + 1]); w.y = cvt_pk_bf16(s[8 * s2 + 2], s[8 * s2 + 3]);
            w.z = cvt_pk_bf16(s[8 * s2 + 4], s[8 * s2 + 5]); w.w = cvt_pk_bf16(s[8 * s2 + 6], s[8 * s2 + 7]);
            pb[s2] = __builtin_bit_cast(bf16x8, w);
        }
#pragma unroll
        for (int dt = 0; dt < 2; ++dt) {
            const bf16* vrow = Vt + (size_t)(h * 64 + 32 * dt + c) * M + mk0 + 4 * hh;
#pragma unroll
            for (int s2 = 0; s2 < 2; ++s2) {
                const u32x2 lo = *(const u32x2*)(vrow + 16 * s2), hi = *(const u32x2*)(vrow + 16 * s2 + 8);
                const u32x4 w = {lo.x, lo.y, hi.x, hi.y};
                if (dt == 0) o0 = MFMA32(__builtin_bit_cast(bf16x8, w), pb[s2], o0); else o1 = MFMA32(__builtin_bit_cast(bf16x8, w), pb[s2], o1);
            }
        }
    }
    const float inv = 1.f / l;
    bf16* orow = yA + mq * 512 + h * 64;
#pragma unroll
    for (int r = 0; r < 16; ++r) {
        orow[crow(r, hh)] = (bf16)(cvt_pk_bf16(o0[r] * inv, 0.f) & 0xffffu);
        orow[32 + crow(r, hh)] = (bf16)(cvt_pk_bf16(o1[r] * inv, 0.f) & 0xffffu);
    }
}

template <int TYPE>
DI void scan_local(int chunk, const unsigned char* ws, unsigned char* ob, int lane) {
    const bf16* AA = (const bf16*)(ws + WS_AA); const bf16* BB = (const bf16*)(ws + WS_BB); const bf16* K2 = (const bf16*)(ws + WS_K2); const bf16* WR = (const bf16*)(ws + WS_WR);
    const float* WW = (const float*)(ws + WS_WW); const bf16* VV = (const bf16*)(ws + WS_VV); const float* SC = (const float*)(ws + WS_SC);
    const int bh = chunk >> 7, b = bh >> 3, h = bh & 7, cc = chunk & 127;
    const int l4 = lane & 3, rg = lane >> 2;
    const size_t m0 = (size_t)b * SEQ + 64 * cc;
    const int colb = h * 64 + 16 * l4;
    float s[4][16];
#pragma unroll
    for (int rr = 0; rr < 4; ++rr)
#pragma unroll
        for (int jj = 0; jj < 16; ++jj) s[rr][jj] = (TYPE == 0 && (16 * l4 + jj == 4 * rg + rr)) ? 1.f : 0.f;
    bf16* Yo = (bf16*)(ob + (TYPE == 0 ? O_YI : O_YL)) + (size_t)chunk * 4096;
    u32x4 raa0, raa1, rbb0, rbb1, rk20 = {0, 0, 0, 0}, rk21 = {0, 0, 0, 0}, rwr0, rwr1; f32x4 rw0, rw1, rw2, rw3, rsc; u32x2 rv = {0, 0};
    const unsigned off0 = (unsigned)((m0 * 512 + colb) * 2), voff0 = (unsigned)((m0 * 512 + h * 64 + 4 * rg) * 2), soff0 = (unsigned)((m0 * 8 + h) * 16);
#define SCAN_LOAD1(tt) do { const unsigned o_ = off0 + (unsigned)(tt) * 1024u; \
        raa0 = *(const u32x4*)((const char*)AA + o_); raa1 = *(const u32x4*)((const char*)AA + o_ + 16); rwr0 = *(const u32x4*)((const char*)WR + o_); rwr1 = *(const u32x4*)((const char*)WR + o_ + 16); \
        rsc = *(const f32x4*)((const char*)SC + soff0 + (unsigned)(tt) * 128u); \
        if (TYPE == 1) { rv = *(const u32x2*)((const char*)VV + voff0 + (unsigned)(tt) * 1024u); } } while (0)
#define SCAN_LOAD2(tt) do { const unsigned o_ = off0 + (unsigned)(tt) * 1024u; \
        rbb0 = *(const u32x4*)((const char*)BB + o_); rbb1 = *(const u32x4*)((const char*)BB + o_ + 16); \
        if (TYPE == 1) { rk20 = *(const u32x4*)((const char*)K2 + o_); rk21 = *(const u32x4*)((const char*)K2 + o_ + 16); } } while (0)
#define SCAN_LOAD3(tt) do { const unsigned o_ = 2u * (off0 + (unsigned)(tt) * 1024u); \
        rw0 = *(const f32x4*)((const char*)WW + o_); rw1 = *(const f32x4*)((const char*)WW + o_ + 16); rw2 = *(const f32x4*)((const char*)WW + o_ + 32); rw3 = *(const f32x4*)((const char*)WW + o_ + 48); } while (0)
    SCAN_LOAD1(0); SCAN_LOAD2(0); SCAN_LOAD3(0);
    for (int t = 0; t < 64; ++t) {
        const int mn = t < 63 ? t + 1 : 63;
        float aa[16], wr[16];
#pragma unroll
        for (int e = 0; e < 4; ++e) { aa[2 * e] = bflo(raa0[e]); aa[2 * e + 1] = bfhi(raa0[e]); aa[8 + 2 * e] = bflo(raa1[e]); aa[8 + 2 * e + 1] = bfhi(raa1[e]);
                                      wr[2 * e] = bflo(rwr0[e]); wr[2 * e + 1] = bfhi(rwr0[e]); wr[8 + 2 * e] = bflo(rwr1[e]); wr[8 + 2 * e + 1] = bfhi(rwr1[e]); }
        const float br = rsc.x, kr = rsc.y;
        float vr[4] = {0.f, 0.f, 0.f, 0.f};
        if (TYPE == 1) { vr[0] = bflo(rv.x); vr[1] = bfhi(rv.x); vr[2] = bflo(rv.y); vr[3] = bfhi(rv.y); }
        __builtin_amdgcn_sched_barrier(0);
        SCAN_LOAD1(mn);
        __builtin_amdgcn_sched_barrier(0);
        float sa[4], yv[4];
#pragma unroll
        for (int rr = 0; rr < 4; ++rr) {
            float p1 = 0.f, p1b = 0.f, p2 = 0.f, p2b = 0.f;
#pragma unroll
            for (int jj = 0; jj < 16; jj += 2) { p1 = fmaf(s[rr][jj], aa[jj], p1); p1b = fmaf(s[rr][jj + 1], aa[jj + 1], p1b); p2 = fmaf(s[rr][jj], wr[jj], p2); p2b = fmaf(s[rr][jj + 1], wr[jj + 1], p2b); }
            sa[rr] = quad_sum(p1 + p1b);
            const float yp = quad_sum(p2 + p2b);
            yv[rr] = yp + sa[rr] * br + (TYPE == 1 ? vr[rr] * kr : 0.f);
        }
        if (l4 == 0) { u32x2 w; w.x = cvt_pk_bf16(yv[0], yv[1]); w.y = cvt_pk_bf16(yv[2], yv[3]); *(u32x2*)(Yo + t * 64 + 4 * rg) = w; }
        float bb[16], k2[16];
#pragma unroll
        for (int e = 0; e < 4; ++e) { bb[2 * e] = bflo(rbb0[e]); bb[2 * e + 1] = bfhi(rbb0[e]); bb[8 + 2 * e] = bflo(rbb1[e]); bb[8 + 2 * e + 1] = bfhi(rbb1[e]);
                                      k2[2 * e] = bflo(rk20[e]); k2[2 * e + 1] = bfhi(rk20[e]); k2[8 + 2 * e] = bflo(rk21[e]); k2[8 + 2 * e + 1] = bfhi(rk21[e]); }
        __builtin_amdgcn_sched_barrier(0);
        SCAN_LOAD2(mn);
        __builtin_amdgcn_sched_barrier(0);
        {
            float wv[16];
#pragma unroll
            for (int e = 0; e < 4; ++e) { wv[e] = rw0[e]; wv[4 + e] = rw1[e]; wv[8 + e] = rw2[e]; wv[12 + e] = rw3[e]; }
            if (TYPE == 1) {
#pragma unroll
                for (int rr = 0; rr < 4; ++rr)
#pragma unroll
                    for (int jj = 0; jj < 16; ++jj) s[rr][jj] = fmaf(s[rr][jj], wv[jj], fmaf(sa[rr], bb[jj], vr[rr] * k2[jj]));
            } else {
#pragma unroll
                for (int rr = 0; rr < 4; ++rr)
#pragma unroll
                    for (int jj = 0; jj < 16; ++jj) s[rr][jj] = fmaf(s[rr][jj], wv[jj], sa[rr] * bb[jj]);
            }
        }
        __builtin_amdgcn_sched_barrier(0);
        SCAN_LOAD3(mn);
        __builtin_amdgcn_sched_barrier(0);
    }
#undef SCAN_LOAD1
#undef SCAN_LOAD2
#undef SCAN_LOAD3
    if (TYPE == 0) {
        bf16* Mt = (bf16*)(ob + O_MT) + (size_t)chunk * 4096;
#pragma unroll
        for (int jj = 0; jj < 16; ++jj) { u32x2 w; w.x = cvt_pk_bf16(s[0][jj], s[1][jj]); w.y = cvt_pk_bf16(s[2][jj], s[3][jj]); *(u32x2*)(Mt + (16 * l4 + jj) * 64 + 4 * rg) = w; }
    } else {
        bf16* Sl = (bf16*)(ob + O_SL) + (size_t)chunk * 4096 + (size_t)(rg >> 2) * 1024 + (size_t)(16 * (rg & 3)) * 16 + 4 * l4;
#pragma unroll
        for (int jj = 0; jj < 16; ++jj) { u32x2 w; w.x = cvt_pk_bf16(s[0][jj], s[1][jj]); w.y = cvt_pk_bf16(s[2][jj], s[3][jj]); *(u32x2*)(Sl + jj * 16) = w; }
    }
}

#define MFMA16(a, b, c) __builtin_amdgcn_mfma_f32_16x16x32_bf16((a), (b), (c), 0, 0, 0)
DI void scan_prop(int task, unsigned char* ws, const unsigned char* ob, LAS bf16* sl, int lane) {
    const int bh = task >> 2, ib = task & 3, c = lane & 15, q = lane >> 4;
    const bf16* MtB = (const bf16*)(ob + O_MT) + (size_t)bh * 128 * 4096 + (size_t)c * 64 + 8 * q;
    const bf16* SlB = (const bf16*)(ob + O_SL) + (size_t)bh * 128 * 4096 + (size_t)ib * 1024 + (size_t)lane * 16;
    bf16* Sch = (bf16*)(ws + WS_SCH) + (size_t)bh * 128 * 4096 + (size_t)(16 * ib + (lane & 15)) * 64 + 8 * q;
    f32x4 acc[4];
#pragma unroll
    for (int nt = 0; nt < 4; ++nt) acc[nt] = (f32x4){0.f, 0.f, 0.f, 0.f};
    bf16x8 bm[2][4]; u32x4 sl0, sl1;
#define PROP_LOAD(cc_) do { const size_t cb_ = (size_t)(cc_) * 4096; \
        _Pragma("unroll") for (int ks = 0; ks < 2; ++ks) _Pragma("unroll") for (int nt = 0; nt < 4; ++nt) bm[ks][nt] = *(const bf16x8*)(MtB + cb_ + nt * 1024 + 32 * ks); \
        sl0 = *(const u32x4*)(SlB + cb_); sl1 = *(const u32x4*)(SlB + cb_ + 8); } while (0)
    PROP_LOAD(0);
    for (int cc = 0; cc < 128; ++cc) {
#pragma unroll
        for (int nt = 0; nt < 4; ++nt)
#pragma unroll
            for (int rp = 0; rp < 4; ++rp) sl[(4 * q + rp) * 72 + 16 * nt + c] = (bf16)(cvt_pk_bf16(acc[nt][rp], 0.f) & 0xffffu);
        bf16x8 cm[2][4];
#pragma unroll
        for (int ks = 0; ks < 2; ++ks)
#pragma unroll
            for (int nt = 0; nt < 4; ++nt) cm[ks][nt] = bm[ks][nt];
#pragma unroll
        for (int e = 0; e < 4; ++e) { acc[0][e] = (e & 1) ? bfhi(sl0[e >> 1]) : bflo(sl0[e >> 1]); acc[1][e] = (e & 1) ? bfhi(sl0[2 + (e >> 1)]) : bflo(sl0[2 + (e >> 1)]);
                                      acc[2][e] = (e & 1) ? bfhi(sl1[e >> 1]) : bflo(sl1[e >> 1]); acc[3][e] = (e & 1) ? bfhi(sl1[2 + (e >> 1)]) : bflo(sl1[2 + (e >> 1)]); }
        { const int cn = cc < 127 ? cc + 1 : 127; PROP_LOAD(cn); }
        const bf16x8 a0 = *(const LAS bf16x8*)(sl + (lane & 15) * 72 + 8 * q), a1 = *(const LAS bf16x8*)(sl + (lane & 15) * 72 + 32 + 8 * q);
        *(bf16x8*)(Sch + (size_t)cc * 4096) = a0; *(bf16x8*)(Sch + (size_t)cc * 4096 + 32) = a1;
#pragma unroll
        for (int nt = 0; nt < 4; ++nt) { acc[nt] = MFMA16(a0, cm[0][nt], acc[nt]); acc[nt] = MFMA16(a1, cm[1][nt], acc[nt]); }
    }
#undef PROP_LOAD
}

DI void scan_out(int task, const Params& p, int lane) {
    unsigned char* ws = p.ws; const unsigned char* ob = (const unsigned char*)p.out;
    const int chunk = task >> 2, mt = task & 3, bh = chunk >> 7, b = bh >> 3, h = bh & 7, cc = chunk & 127, c = lane & 15, q = lane >> 4;
    const size_t cb = (size_t)chunk * 4096;
    const bf16* YI = (const bf16*)(ob + O_YI) + cb; const bf16* YL = (const bf16*)(ob + O_YL) + cb; const bf16* Sch = (const bf16*)(ws + WS_SCH) + cb;
    const bf16* VV = (const bf16*)(ws + WS_VV); const bf16* GG = (const bf16*)(ws + WS_GG); const float* SC = (const float*)(ws + WS_SC); bf16* yB = (bf16*)(ws + WS_YB);
    f32x4 acc[4];
#pragma unroll
    for (int nt = 0; nt < 4; ++nt)
#pragma unroll
        for (int rp = 0; rp < 4; ++rp) acc[nt][rp] = bflo((unsigned)YL[(16 * mt + 4 * q + rp) * 64 + 16 * nt + c]);
#pragma unroll
    for (int ks = 0; ks < 2; ++ks) {
        const bf16x8 a = *(const bf16x8*)(YI + (16 * mt + (lane & 15)) * 64 + 32 * ks + 8 * q);
#pragma unroll
        for (int nt = 0; nt < 4; ++nt) { const bf16x8 bs = *(const bf16x8*)(Sch + (16 * nt + c) * 64 + 32 * ks + 8 * q); acc[nt] = MFMA16(a, bs, acc[nt]); }
    }
#pragma unroll
    for (int rp = 0; rp < 4; ++rp) {
        const size_t m = (size_t)b * SEQ + 64 * cc + 16 * mt + 4 * q + rp;
        float sm = (acc[0][rp] + acc[1][rp]) + (acc[2][rp] + acc[3][rp]);
        const float mean = row16_sum(sm) * (1.f / 64.f);
        float sv = 0.f;
#pragma unroll
        for (int nt = 0; nt < 4; ++nt) { const float d = acc[nt][rp] - mean; sv += d * d; }
        const float rstd = rsqrtf(row16_sum(sv) * (1.f / 64.f) + GN_EPS);
        const float bonus = SC[(m * 8 + h) * 4 + 2];
#pragma unroll
        for (int nt = 0; nt < 4; ++nt) {
            const int col = h * 64 + 16 * nt + c;
            const float yn = (acc[nt][rp] - mean) * rstd * p.in[I_LNW][col] + p.in[I_LNB][col];
            const float o = (yn + bonus * bflo((unsigned)VV[m * 512 + col])) * bflo((unsigned)GG[m * 512 + col]);
            yB[m * 512 + col] = (bf16)(cvt_pk_bf16(o, 0.f) & 0xffffu);
        }
    }
}

DI void row_pass1(const float* x, const float* z, const float* g1, const float* g2, float* out, bf16* hf, int lane) {
    f32x4 v[4]; float s = 0.f;
#pragma unroll
    for (int j = 0; j < 4; ++j) { v[j] = ((const f32x4*)z)[lane + 64 * j]; s += (v[j].x * v[j].x + v[j].y * v[j].y) + (v[j].z * v[j].z + v[j].w * v[j].w); }
    const float rs = rsqrtf(wave_sum(s) * (1.f / D) + RMS_EPS);
    float s2 = 0.f;
#pragma unroll
    for (int j = 0; j < 4; ++j) { const f32x4 xx = ((const f32x4*)x)[lane + 64 * j], gg = ((const f32x4*)g1)[lane + 64 * j]; v[j] = xx + v[j] * rs * gg; ((f32x4*)out)[lane + 64 * j] = v[j];
        s2 += (v[j].x * v[j].x + v[j].y * v[j].y) + (v[j].z * v[j].z + v[j].w * v[j].w); }
    const float rs2 = rsqrtf(wave_sum(s2) * (1.f / D) + RMS_EPS);
#pragma unroll
    for (int j = 0; j < 4; ++j) { const f32x4 gg = ((const f32x4*)g2)[lane + 64 * j]; u32x2 w; w.x = cvt_pk_bf16(v[j].x * rs2 * gg.x, v[j].y * rs2 * gg.y); w.y = cvt_pk_bf16(v[j].z * rs2 * gg.z, v[j].w * rs2 * gg.w); ((u32x2*)hf)[lane + 64 * j] = w; }
}
DI void row_pass2(const float* u, const float* g, float* out, int lane) {
    f32x4 v[4]; float s = 0.f;
#pragma unroll
    for (int j = 0; j < 4; ++j) { v[j] = ((const f32x4*)u)[lane + 64 * j]; s += (v[j].x * v[j].x + v[j].y * v[j].y) + (v[j].z * v[j].z + v[j].w * v[j].w); }
    const float rs = rsqrtf(wave_sum(s) * (1.f / D) + RMS_EPS);
#pragma unroll
    for (int j = 0; j < 4; ++j) { const f32x4 xx = ((const f32x4*)out)[lane + 64 * j], gg = ((const f32x4*)g)[lane + 64 * j]; ((f32x4*)out)[lane + 64 * j] = xx + v[j] * rs * gg; }
}

template <int MODE> DI void run_gemm(LAS unsigned char* lds, const bf16* A, const bf16* Bt, int m, int n, int k, const pg8::Epi<MODE>& E) {
    __syncthreads();
    pg8::Gemm g{A, Bt, m, n, k}; pg8::StaticOrder S; S.init(m, n, (int)gridDim.x, (int)blockIdx.x);
    pg8::gemm_phase<pg8::Epi<MODE>, pg8::StaticOrder, PG8_ALIGN, PG8_SP2>(lds, g, S, E);
    __syncthreads();
}

__global__ void __launch_bounds__(NTHR) fwd(Params p) {
    extern __shared__ __attribute__((aligned(16))) unsigned char lds_raw[];
    LAS unsigned char* lds = (LAS unsigned char*)lds_raw;
    cg::grid_group grid = cg::this_grid();
#define PHASE_IDS() int tid = threadIdx.x; asm volatile("" : "+v"(tid) :: "memory"); const int lane = tid & 63, wave = __builtin_amdgcn_readfirstlane(tid >> 6); \
    const int gw = blockIdx.x * NWAVES + wave, NGW = gridDim.x * NWAVES; (void)gw; (void)NGW; (void)lane
    unsigned char* ws = p.ws; unsigned char* ob = (unsigned char*)p.out;
    volatile LAS unsigned* MISC = (volatile LAS unsigned*)(lds + MISC_OFF);
    if (threadIdx.x < 64) MISC[threadIdx.x] = 0u;
    __syncthreads();
    const XcdBarrier bar = xcd_barrier_post((unsigned*)ws, MISC + 8);
#define GRID_BAR() xcd_barrier(bar)

    { PHASE_IDS(); phase0(p, lds, wave, lane); }
#if PROBE == 7
    { PHASE_IDS(); phase0(p, lds, wave, lane); }
#endif
#if PROBE == 8
    for (int i_ = 0; i_ < 10; ++i_) grid.sync();
#endif
    GRID_BAR();

    { pg8::Epi<0> E{}; E.o0 = (bf16*)(ws + WS_Q); E.o1 = (bf16*)(ws + WS_K); E.o2 = (bf16*)ob; E.ldc = 512;
      run_gemm<0>(lds, (const bf16*)(ws + WS_XN), (const bf16*)(ws + W_A), M, 2816, 1024, E); }
    { pg8::Epi<1> E{}; E.o0 = (bf16*)(ws + WS_VT); E.ldc = M;
      run_gemm<1>(lds, (const bf16*)(ws + W_V), (const bf16*)(ws + WS_XN), 512, M, 1024, E); }
#if PROBE == 5
    { pg8::Epi<0> E{}; E.o0 = (bf16*)(ws + WS_Q); E.o1 = (bf16*)(ws + WS_K); E.o2 = (bf16*)ob; E.ldc = 512;
      run_gemm<0>(lds, (const bf16*)(ws + WS_XN), (const bf16*)(ws + W_A), M, 2816, 1024, E); }
#endif
#if PROBE == 6
    { pg8::Epi<1> E{}; E.o0 = (bf16*)(ws + WS_VT); E.ldc = M;
      run_gemm<1>(lds, (const bf16*)(ws + W_V), (const bf16*)(ws + WS_XN), 512, M, 1024, E); }
#endif
    GRID_BAR();

    { PHASE_IDS(); phase2(p, lds, wave, lane); }
#if PROBE == 1
    { PHASE_IDS(); phase2(p, lds, wave, lane); }
#endif
    GRID_BAR();

    {
        PHASE_IDS();
        LAS float* biasL = (LAS float*)lds;
        for (int i = tid; i < 8 * 320; i += NTHR) biasL[i] = p.in[I_RELB][i];
        __syncthreads();
        const int hw = blockIdx.x * 4 + (wave & 3), NHW = NGW >> 1;
        if (wave & 4) { for (int t = hw; t < 4096; t += NHW) { if (t & 1) scan_local<1>(t >> 1, ws, ob, lane); else scan_local<0>(t >> 1, ws, ob, lane); } }
        else { for (int t = hw; t < 4096; t += NHW) attn_task(t, (const bf16*)(ws + WS_Q), (const bf16*)(ws + WS_K), (const bf16*)(ws + WS_VT), (bf16*)(ws + WS_Q), biasL, lane); }
#if PROBE == 3
        for (int t = gw; t < 4096; t += NGW) { if (t & 1) scan_local<1>(t >> 1, ws, ob, lane); else scan_local<0>(t >> 1, ws, ob, lane); }
#endif
    }
    GRID_BAR();
#if PROBE == 2
    {
        PHASE_IDS();
        LAS float* biasL = (LAS float*)lds;
        for (int t = gw; t < 4096; t += NGW) attn_task(t, (const bf16*)(ws + WS_Q), (const bf16*)(ws + WS_K), (const bf16*)(ws + WS_VT), (bf16*)(ws + WS_K), biasL, lane);
    }
    GRID_BAR();
#endif

    { PHASE_IDS(); if (gw < 64) scan_prop(gw, ws, ob, (LAS bf16*)(lds + wave * 2304), lane); }
    GRID_BAR();

    { PHASE_IDS(); for (int t = gw; t < 8192; t += NGW) scan_out(t, p, lane); }
#if PROBE == 4
    { PHASE_IDS(); for (int t = gw; t < 8192; t += NGW) scan_out(t, p, lane); }
#endif
    { pg8::Epi<2> E{}; E.o0 = (bf16*)(ws + WS_G); E.ldc = 2048; E.bias = p.in[I_GBIAS];
      run_gemm<2>(lds, (const bf16*)(ws + WS_XN), (const bf16*)(ws + W_G), M, 2048, 1024, E); }
    GRID_BAR();

    { pg8::Epi<3> E{}; E.o0 = (bf16*)(ws + WS_TMP); E.ldc = 1024; E.gate = (const bf16*)(ws + WS_G); E.gcol0 = 0;
      run_gemm<3>(lds, (const bf16*)(ws + WS_Q), (const bf16*)(ws + W_PA), M, 1024, 512, E); }
    { pg8::Epi<4> E{}; E.o0 = (bf16*)(ws + WS_MG); E.ldc = 1024; E.gate = (const bf16*)(ws + WS_G); E.gcol0 = 1024; E.tmp = (const bf16*)(ws + WS_TMP);
      run_gemm<4>(lds, (const bf16*)(ws + WS_YB), (const bf16*)(ws + W_PB), M, 1024, 512, E); }
    GRID_BAR();

    { pg8::Epi<5> E{}; E.of = (float*)(ws + WS_Z); E.ldc = 1024;
      run_gemm<5>(lds, (const bf16*)(ws + WS_MG), (const bf16*)(ws + W_O), M, 1024, 1024, E); }
    GRID_BAR();
    { PHASE_IDS(); for (int m = gw; m < M; m += NGW)
        row_pass1(p.in[I_X] + (size_t)m * D, (const float*)(ws + WS_Z) + (size_t)m * D, p.in[I_POSTG], p.in[I_PREF], p.out + (size_t)m * D, (bf16*)(ws + WS_HF) + (size_t)m * D, lane); }
    GRID_BAR();

    { pg8::Epi<6> E{}; E.o0 = (bf16*)(ws + WS_H); E.ldc = FF;
      run_gemm<6>(lds, (const bf16*)(ws + WS_HF), (const bf16*)(ws + W_UP), M, FF, 1024, E); }
#if PROBE == 9
    { pg8::Epi<6> E{}; E.o0 = (bf16*)(ws + WS_H); E.ldc = FF;
      run_gemm<6>(lds, (const bf16*)(ws + WS_HF), (const bf16*)(ws + W_UP), M, FF, 1024, E); }
#endif
    GRID_BAR();

    { pg8::Epi<5> E{}; E.of = (float*)(ws + WS_Z); E.ldc = 1024;
      run_gemm<5>(lds, (const bf16*)(ws + WS_H), (const bf16*)(ws + W_DN), M, 1024, FF, E); }
    GRID_BAR();
    PHASE_IDS(); for (int m = gw; m < M; m += NGW) row_pass2((const float*)(ws + WS_Z) + (size_t)m * D, p.in[I_POSTF], p.out + (size_t)m * D, lane);
}

extern "C" void kernel_launch(void* const* d_in, const int* in_sizes, int n_in, void* d_out, int out_size,
                              void* d_ws, size_t ws_size, hipStream_t stream) {
    static int grid_blocks = 0;
    if (!grid_blocks) {
        int dev = 0, cus = 0, per_cu = 0;
        (void)hipGetDevice(&dev);
        (void)hipDeviceGetAttribute(&cus, hipDeviceAttributeMultiprocessorCount, dev);
        (void)hipFuncSetAttribute((const void*)fwd, hipFuncAttributeMaxDynamicSharedMemorySize, LDS_BYTES);
        (void)hipOccupancyMaxActiveBlocksPerMultiprocessor(&per_cu, (const void*)fwd, NTHR, LDS_BYTES);
        if (per_cu < 1) per_cu = 1;
        grid_blocks = cus * per_cu;
        if (n_in != 24 || out_size != M * D || ws_size < 256 * MiB) fprintf(stderr, "kernel_launch: unexpected shapes n_in %d out %d ws %zu\n", n_in, out_size, ws_size);
    }
    (void)hipMemsetAsync(d_ws, 0, 16384, stream);
    Params p{};
    for (int i = 0; i < 24; ++i) p.in[i] = (const float*)d_in[i];
    p.out = (float*)d_out; p.ws = (unsigned char*)d_ws;
    void* args[] = {&p};
    hipError_t e = hipLaunchCooperativeKernel((void*)fwd, dim3(grid_blocks), dim3(NTHR), args, LDS_BYTES, stream);
    if (e != hipSuccess) fprintf(stderr, "cooperative launch failed: %s (grid %d)\n", hipGetErrorString(e), grid_blocks);
}
```
